# Optimizing an MI355X kernel written in HIP

```python
import math
import jax, jax.numpy as jnp
from jax import lax
import numpy as np

D_MODEL = 1024
BATCH = 16
SEQ = 2048
DEPTH = 1

N_META = 16
Q_BLOCK = 128
N_DIFF_HEADS = 4
DIFF_QK_DIM = 64
DIFF_V_DIM = 2 * DIFF_QK_DIM
DIFF_WIDTH = N_DIFF_HEADS * DIFF_V_DIM
N_SB_HEADS = 8
SB_HEAD_DIM = 64
SB_WIDTH = N_SB_HEADS * SB_HEAD_DIM
MIX_WIDTH = DIFF_WIDTH + SB_WIDTH
PROJ_SIZES = (
    N_DIFF_HEADS * 2 * DIFF_QK_DIM,
    N_DIFF_HEADS * 2 * DIFF_QK_DIM,
    N_DIFF_HEADS * DIFF_V_DIM,
    N_SB_HEADS * SB_HEAD_DIM,
    N_SB_HEADS * SB_HEAD_DIM,
    N_SB_HEADS * SB_HEAD_DIM,
)
PROJ_WIDTH = sum(PROJ_SIZES)
D_FF = 2816
CONV_WIDTH = 3
EPS = 1e-6

kernel_name = "hymba_diffattn_stickbreaking_convffn"


def _rmsnorm(x, g):
    xf = x.astype(jnp.float32)
    xf = xf * lax.rsqrt(jnp.mean(xf * xf, axis=-1, keepdims=True) + EPS)
    return xf.astype(x.dtype) * g


def _alibi_slopes(n_heads):
    start = 2.0 ** (-8.0 / n_heads)
    return jnp.asarray([start ** (i + 1) for i in range(n_heads)], dtype=jnp.float32)


def _lambda_init(layer_idx):
    return 0.8 - 0.6 * math.exp(-0.3 * layer_idx)


def _attend_block(qd1, qd2, qs, qpos, kd1, kd2, vd, ks, vs, kpos, slopes, lam):
    dist = qpos[:, None] - kpos[None, :]
    causal = dist >= 0
    alibi = -slopes[:, None, None] * dist.astype(jnp.float32)[None]

    def softmax_map(q, k):
        s = jnp.einsum("bhtd,bhsd->bhts", q, k).astype(jnp.float32) * (DIFF_QK_DIM ** -0.5) + alibi
        return jax.nn.softmax(jnp.where(causal, s, -jnp.inf), axis=-1)

    a_diff = softmax_map(qd1, kd1) - lam * softmax_map(qd2, kd2)
    o_diff = jnp.einsum("bhts,bhse->bhte", a_diff.astype(vd.dtype), vd)
    strict = dist > 0
    z = jnp.einsum("bhtd,bhsd->bhts", qs, ks).astype(jnp.float32) * (SB_HEAD_DIM ** -0.5)
    sp = jnp.where(strict, jax.nn.softplus(z), 0.0)
    log_a = z - lax.cumsum(sp, axis=3, reverse=True)
    a_sb = jnp.exp(jnp.where(strict, log_a, -jnp.inf))
    o_sb = jnp.einsum("bhts,bhse->bhte", a_sb.astype(vs.dtype), vs)
    return o_diff, o_sb


def _token_mixer(xn, w_in, lam_q1, lam_k1, lam_q2, lam_k2, g_diff, g_sb, w_out, layer_idx):
    B, L, _ = xn.shape
    n_blocks = (L - N_META) // Q_BLOCK
    proj = xn @ w_in
    dq, dk, dv, sq, sk, sv = jnp.split(proj, list(np.cumsum(PROJ_SIZES)[:-1]), axis=-1)

    def heads(t, h, d):
        return t.reshape(B, L, h, d).transpose(0, 2, 1, 3)

    dq = dq.reshape(B, L, N_DIFF_HEADS, 2, DIFF_QK_DIM)
    dk = dk.reshape(B, L, N_DIFF_HEADS, 2, DIFF_QK_DIM)
    qd1, qd2 = dq[..., 0, :].transpose(0, 2, 1, 3), dq[..., 1, :].transpose(0, 2, 1, 3)
    kd1, kd2 = dk[..., 0, :].transpose(0, 2, 1, 3), dk[..., 1, :].transpose(0, 2, 1, 3)
    vd = heads(dv, N_DIFF_HEADS, DIFF_V_DIM)
    qs, ks, vs = heads(sq, N_SB_HEADS, SB_HEAD_DIM), heads(sk, N_SB_HEADS, SB_HEAD_DIM), heads(sv, N_SB_HEADS, SB_HEAD_DIM)

    lam_init = _lambda_init(layer_idx)
    lam = (jnp.exp(jnp.sum(lam_q1.astype(jnp.float32) * lam_k1.astype(jnp.float32)))
           - jnp.exp(jnp.sum(lam_q2.astype(jnp.float32) * lam_k2.astype(jnp.float32))) + lam_init)
    slopes = _alibi_slopes(N_DIFF_HEADS)
    pos = jnp.arange(L, dtype=jnp.int32)

    m = N_META
    od_meta, os_meta = _attend_block(qd1[:, :, :m], qd2[:, :, :m], qs[:, :, :m], pos[:m],
                                     kd1[:, :, :m], kd2[:, :, :m], vd[:, :, :m],
                                     ks[:, :, :m], vs[:, :, :m], pos[:m], slopes, lam)

    def to_blocks(t):
        h, d = t.shape[1], t.shape[3]
        return t[:, :, m:].reshape(B, h, n_blocks, Q_BLOCK, d).transpose(2, 0, 1, 3, 4)

    def from_blocks(t):
        return t.transpose(1, 2, 0, 3, 4).reshape(B, t.shape[2], n_blocks * Q_BLOCK, t.shape[4])

    qpos_blocks = pos[m:].reshape(n_blocks, Q_BLOCK)
    od_real, os_real = lax.map(
        lambda a: _attend_block(a[0], a[1], a[2], a[3], kd1, kd2, vd, ks, vs, pos, slopes, lam),
        (to_blocks(qd1), to_blocks(qd2), to_blocks(qs), qpos_blocks))
    o_diff = jnp.concatenate([od_meta, from_blocks(od_real)], axis=2)
    o_sb = jnp.concatenate([os_meta, from_blocks(os_real)], axis=2)

    o_diff = _rmsnorm(o_diff, g_diff) * (1.0 - lam_init)
    o_sb = _rmsnorm(o_sb, g_sb)
    merged = jnp.concatenate([o_diff.transpose(0, 2, 1, 3).reshape(B, L, DIFF_WIDTH),
                              o_sb.transpose(0, 2, 1, 3).reshape(B, L, SB_WIDTH)], axis=-1)
    return merged @ w_out


def _conv_ffn(xn, w_up, conv_w, conv_b, w_down):
    L = xn.shape[1]
    h = xn @ w_up
    hp = jnp.pad(h, ((0, 0), (CONV_WIDTH - 1, 0), (0, 0)))
    hc = conv_b + sum(conv_w[k] * hp[:, k:k + L] for k in range(CONV_WIDTH))
    gate, up = jnp.split(hc, 2, axis=-1)
    return (jax.nn.silu(gate) * up) @ w_down


def setup_inputs(seed: int = 0) -> dict:
    key = jax.random.key(seed)
    ks = jax.random.split(key, 16)
    f32 = jnp.float32
    nrm = lambda k, shape, s: jax.random.normal(k, shape, f32) * s
    return {
        "x": nrm(ks[0], (BATCH, SEQ, D_MODEL), 1.0),
        "meta_tokens": nrm(ks[1], (N_META, D_MODEL), 1.0),
        "g_attn": 1.0 + nrm(ks[2], (DEPTH, D_MODEL), 0.02),
        "w_in": nrm(ks[3], (DEPTH, D_MODEL, PROJ_WIDTH), D_MODEL ** -0.5),
        "lam_q1": nrm(ks[4], (DEPTH, DIFF_QK_DIM), 0.1),
        "lam_k1": nrm(ks[5], (DEPTH, DIFF_QK_DIM), 0.1),
        "lam_q2": nrm(ks[6], (DEPTH, DIFF_QK_DIM), 0.1),
        "lam_k2": nrm(ks[7], (DEPTH, DIFF_QK_DIM), 0.1),
        "g_diff": 1.0 + nrm(ks[8], (DEPTH, DIFF_V_DIM), 0.02),
        "g_sb": 1.0 + nrm(ks[9], (DEPTH, SB_HEAD_DIM), 0.02),
        "w_out": nrm(ks[10], (DEPTH, MIX_WIDTH, D_MODEL), MIX_WIDTH ** -0.5),
        "g_ffn": 1.0 + nrm(ks[11], (DEPTH, D_MODEL), 0.02),
        "w_up": nrm(ks[12], (DEPTH, D_MODEL, 2 * D_FF), D_MODEL ** -0.5),
        "conv_w": nrm(ks[13], (DEPTH, CONV_WIDTH, 2 * D_FF), CONV_WIDTH ** -0.5),
        "conv_b": nrm(ks[14], (DEPTH, 2 * D_FF), 0.01),
        "w_down": nrm(ks[15], (DEPTH, D_FF, D_MODEL), D_FF ** -0.5),
        "g_final": 1.0 + nrm(jax.random.fold_in(key, 99), (D_MODEL,), 0.02),
    }


def reference(x, meta_tokens, g_attn, w_in, lam_q1, lam_k1, lam_q2, lam_k2, g_diff, g_sb,
              w_out, g_ffn, w_up, conv_w, conv_b, w_down, g_final):
    B = x.shape[0]
    meta = jnp.broadcast_to(meta_tokens[None].astype(x.dtype), (B, N_META, D_MODEL))
    h = jnp.concatenate([meta, x], axis=1)
    for layer in range(DEPTH):
        h = h + _token_mixer(_rmsnorm(h, g_attn[layer]), w_in[layer], lam_q1[layer], lam_k1[layer],
                             lam_q2[layer], lam_k2[layer], g_diff[layer], g_sb[layer],
                             w_out[layer], layer)
        h = h + _conv_ffn(_rmsnorm(h, g_ffn[layer]), w_up[layer], conv_w[layer], conv_b[layer],
                          w_down[layer])
    return _rmsnorm(h, g_final)[:, N_META:]
```

```cpp
#include <hip/hip_runtime.h>
#include <hip/hip_cooperative_groups.h>
#include <cstdio>
#include <cstdint>
#include <cmath>
namespace cg = cooperative_groups;
namespace pg8 {
#define PG8_LAS __attribute__((address_space(3)))
typedef unsigned short bf16_t;
typedef short bf16x8 __attribute__((ext_vector_type(8)));
typedef float f32x4 __attribute__((ext_vector_type(4)));
typedef unsigned u32x4 __attribute__((ext_vector_type(4)));
constexpr int BM = 256, BK = 64, HALF = 128, HTB = HALF * BK * 2  , STAGE_BYTES = 8 * HTB, NXCD = 8, WGM = 8;

__host__ __device__ __forceinline__ int lds_byte(int r, int c) { const int st = (r >> 4) * 2 + (c >> 5), rr = r & 15, cc = c & 31, ob = rr * 64 + cc * 2; return st * 1024 + (ob ^ (((ob >> 9) & 1) << 5)); }
__host__ __device__ __forceinline__ void stage_rc(int b, int& R, int& C) { const int st = b / 1024, sb = b % 1024, swz = sb ^ (((sb >> 9) & 1) << 5); R = (st >> 1) * 16 + swz / 64; C = (st & 1) * 32 + (swz % 64) / 2; }
__host__ __device__ __forceinline__ int perm32(int rho) { const int n = rho >> 4, i = rho & 15; return 8 * (i >> 2) + 4 * n + (i & 3); }

struct Unit { int pm, pn; };
struct Gemm { const bf16_t* A; const bf16_t* Bt; int M, N, K; };

struct StaticOrder {
    int nM, nN, nwg, G, c;
    __host__ __device__ void init(int M, int N, int G_, int c_) { nM = M / BM; nN = N / BM; nwg = nM * nN; G = G_; c = c_; }
    __host__ __device__ bool next(int i, Unit& u) const {
        const long L = (long)i * G + c; if (L >= nwg) return false;
        int wgid = (int)L; { const int q = nwg / NXCD, r = nwg % NXCD, xcd = wgid % NXCD, off = wgid / NXCD; wgid = (xcd < r ? xcd * (q + 1) : r * (q + 1) + (xcd - r) * q) + off; }
        const int nig = WGM * nN, gid = wgid / nig, fm = gid * WGM, gsz = (nM - fm) < WGM ? (nM - fm) : WGM;
        u.pm = fm + ((wgid % nig) % gsz); u.pn = (wgid % nig) / gsz; return true;
    }
    __device__ __forceinline__ void a_ready(const Unit&) const {}
    __device__ __forceinline__ void done(const Unit&) const {}
};

__device__ __forceinline__ unsigned cvt_pk_bf16(float lo, float hi) { unsigned r; asm volatile("v_cvt_pk_bf16_f32 %0, %1, %2" : "=v"(r) : "v"(lo), "v"(hi)); return r; }
__device__ __forceinline__ u32x4 pack8(const f32x4 v0, const f32x4 v1) { u32x4 w; w.x = cvt_pk_bf16(v0[0], v0[1]); w.y = cvt_pk_bf16(v0[2], v0[3]); w.z = cvt_pk_bf16(v1[0], v1[1]); w.w = cvt_pk_bf16(v1[2], v1[3]); return w; }
struct EpiInProj {
    static constexpr bool PERM = true, AFTER_DRAIN = false;
    bf16_t* QK; size_t qk_stride; bf16_t* Vt; int ldv; float qscale;
    __device__ __forceinline__ void operator()(const f32x4 (&acc)[2][2][4][2], const Unit& u, int wr, int wc, int fr, int fq) const {
        bf16_t* base; int ldc, row0, col0; float sc = 1.f;
        if (u.pm < 129) { int colt = (u.pn - 129) * BM; const int t = colt >> 9; colt &= 511; base = QK + (size_t)t * qk_stride; ldc = 512; row0 = u.pm * BM; col0 = colt; if ((t & 1) == 0) sc = qscale; }
        else { base = Vt; ldc = ldv; row0 = (u.pm - 137) * BM; col0 = u.pn * BM; }
        row0 += wr * 64 + fr; col0 += wc * 32 + 8 * fq;
#pragma unroll
        for (int ai = 0; ai < 2; ++ai)
#pragma unroll
            for (int m = 0; m < 4; ++m) { bf16_t* rowp = base + (size_t)(row0 + ai * HALF + m * 16) * ldc + col0;
#pragma unroll
                for (int bj = 0; bj < 2; ++bj) *(u32x4*)(rowp + bj * HALF) = pack8(acc[ai][bj][m][0] * sc, acc[ai][bj][m][1] * sc); }
    }
};
struct EpiPlain {
    static constexpr bool PERM = true, AFTER_DRAIN = false;
    bf16_t* O; int ldc;
    __device__ __forceinline__ void operator()(const f32x4 (&acc)[2][2][4][2], const Unit& u, int wr, int wc, int fr, int fq) const {
        const int row0 = u.pm * BM + wr * 64 + fr, col0 = u.pn * BM + wc * 32 + 8 * fq;
#pragma unroll
        for (int ai = 0; ai < 2; ++ai)
#pragma unroll
            for (int m = 0; m < 4; ++m) { bf16_t* rowp = O + (size_t)(row0 + ai * HALF + m * 16) * ldc + col0;
#pragma unroll
                for (int bj = 0; bj < 2; ++bj) *(u32x4*)(rowp + bj * HALF) = pack8(acc[ai][bj][m][0], acc[ai][bj][m][1]); }
    }
};
struct EpiRes1 {
    static constexpr bool PERM = true, AFTER_DRAIN = false;
    const float* x; const float* meta; float* h1; bf16_t* h1b; float* part;
    __device__ __forceinline__ void operator()(const f32x4 (&acc)[2][2][4][2], const Unit& u, int wr, int wc, int fr, int fq) const {
        const int row0 = u.pm * BM + wr * 64 + fr, col0 = u.pn * BM + wc * 32 + 8 * fq;
#pragma unroll
        for (int ai = 0; ai < 2; ++ai)
#pragma unroll
            for (int m = 0; m < 4; ++m) {
                const int r = row0 + ai * HALF + m * 16; const bool real = r < 32768, hasres = r < 32784;
                const float* res = real ? x + (size_t)r * 1024 : meta + (size_t)(hasres ? r - 32768 : 0) * 1024;
                float ss = 0.f;
#pragma unroll
                for (int bj = 0; bj < 2; ++bj) { const int c = col0 + bj * HALF;
                    f32x4 v0 = acc[ai][bj][m][0], v1 = acc[ai][bj][m][1];
                    if (hasres) { v0 = v0 + *(const f32x4*)(res + c); v1 = v1 + *(const f32x4*)(res + c + 4); }
                    ss += (v0[0] * v0[0] + v0[1] * v0[1]) + (v0[2] * v0[2] + v0[3] * v0[3]) + (v1[0] * v1[0] + v1[1] * v1[1]) + (v1[2] * v1[2] + v1[3] * v1[3]);
                    if (real) { *(f32x4*)(h1 + (size_t)r * 1024 + c) = v0; *(f32x4*)(h1 + (size_t)r * 1024 + c + 4) = v1; }
                    *(u32x4*)(h1b + (size_t)r * 1024 + c) = pack8(v0, v1); }
                ss += __shfl_xor(ss, 16); ss += __shfl_xor(ss, 32);
                if (fq == 0) part[(size_t)r * 16 + u.pn * 4 + wc] = ss;
            }
    }
};
struct EpiRes2 {
    static constexpr bool PERM = true, AFTER_DRAIN = false;
    float* h; float* part; int rowoff;
    __device__ __forceinline__ void operator()(const f32x4 (&acc)[2][2][4][2], const Unit& u, int wr, int wc, int fr, int fq) const {
        const int row0 = rowoff + u.pm * BM + wr * 64 + fr, col0 = u.pn * BM + wc * 32 + 8 * fq;
#pragma unroll
        for (int ai = 0; ai < 2; ++ai)
#pragma unroll
            for (int m = 0; m < 4; ++m) {
                const int r = row0 + ai * HALF + m * 16; float* hr = h + (size_t)r * 1024;
                float ss = 0.f;
#pragma unroll
                for (int bj = 0; bj < 2; ++bj) { const int c = col0 + bj * HALF;
                    const f32x4 v0 = acc[ai][bj][m][0] + *(const f32x4*)(hr + c), v1 = acc[ai][bj][m][1] + *(const f32x4*)(hr + c + 4);
                    ss += (v0[0] * v0[0] + v0[1] * v0[1]) + (v0[2] * v0[2] + v0[3] * v0[3]) + (v1[0] * v1[0] + v1[1] * v1[1]) + (v1[2] * v1[2] + v1[3] * v1[3]);
                    *(f32x4*)(hr + c) = v0; *(f32x4*)(hr + c + 4) = v1; }
                ss += __shfl_xor(ss, 16); ss += __shfl_xor(ss, 32);
                if (fq == 0) part[(size_t)r * 16 + u.pn * 4 + wc] = ss;
            }
    }
};
struct OrderInProj {
    int G, c;
    __device__ __forceinline__ bool next(int i, Unit& u) const {
        const int L = i * G + c; if (L >= 1548) return false;
        if (L < 1024) { const int x = L & 7, j = (L >> 3) & 31, rnd = L >> 8; u.pm = 32 * rnd + 4 * x + (j >> 3); u.pn = 129 + (j & 7); return true; }
        int V = L - 1024;
        if (V < 516) { if (V < 512) { const int x = V & 7, j = (V >> 3) & 31, r2 = V >> 8; V = r2 * 256 + x * 32 + j; } u.pm = 137 + (V & 3); u.pn = V >> 2; return true; }
        u.pm = 128; u.pn = 129 + (V - 516); return true;
    }
    __device__ __forceinline__ void a_ready(const Unit&) const {}
    __device__ __forceinline__ void done(const Unit&) const {}
};

template <class Epi, class Sched, bool ALIGN_EPI = false, bool SP2 = false>
__device__ __forceinline__ void gemm_phase(PG8_LAS unsigned char* lds, const Gemm g, const Sched& S, const Epi& E) {
    int tid_ = threadIdx.x; asm volatile("" : "+v"(tid_));
    const int tid = tid_, wid = __builtin_amdgcn_readfirstlane(tid >> 6), lane = tid & 63, wr = wid >> 2, wc = wid & 3, fr = lane & 15, fq = lane >> 4;
    const int K = g.K, nt = K / BK;
    unsigned voffA[2], voffB[2];
#pragma unroll
    for (int i = 0; i < 2; ++i) { int R, C; stage_rc(tid * 16 + i * 8192, R, C); const int Rb = Epi::PERM ? ((R & ~31) + perm32(R & 31)) : R;
        voffA[i] = (unsigned)(R * K + C) * 2u; voffB[i] = (unsigned)(Rb * K + C) * 2u; }
    const size_t kstep = (size_t)(BK * 2);
    const size_t hstep = (size_t)HALF * K * 2;
    const size_t tstep = 2 * hstep;
    const unsigned ldsw = (unsigned)wid * 1024u;
    const int aoff = lds_byte(wr * 64 + fr, fq * 8), boff = lds_byte(wc * 32 + fr, fq * 8);
#define PG8_SA(b, h) (((b) * 2 + (h)) * HTB)
#define PG8_SB(b, h) ((4 + (b) * 2 + (h)) * HTB)
#define PG8_STAGE(bufoff, gbase, voff) do { _Pragma("unroll") for (int _i = 0; _i < 2; ++_i) \
        __builtin_amdgcn_global_load_lds((const unsigned*)((const char*)(gbase) + (voff)[_i]), (PG8_LAS unsigned*)(lds + (bufoff) + ldsw + _i * 8192), 16, 0, 0); } while (0)
#define PG8_LDA(dst, b, h) do { _Pragma("unroll") for (int m = 0; m < 4; ++m) _Pragma("unroll") for (int k = 0; k < 2; ++k) dst[m][k] = *(const PG8_LAS bf16x8*)(lds + PG8_SA(b, h) + aoff + m * 2048 + k * 1024); } while (0)
#define PG8_LDB(dst, b, h) do { _Pragma("unroll") for (int n = 0; n < 2; ++n) _Pragma("unroll") for (int k = 0; k < 2; ++k) dst[n][k] = *(const PG8_LAS bf16x8*)(lds + PG8_SB(b, h) + boff + n * 2048 + k * 1024); } while (0)
#define PG8_MMA(ai, bj, At, Bt) do { __builtin_amdgcn_s_setprio(1); _Pragma("unroll") for (int m = 0; m < 4; ++m) _Pragma("unroll") for (int n = 0; n < 2; ++n) _Pragma("unroll") for (int k = 0; k < 2; ++k) \
        acc[ai][bj][m][n] = __builtin_amdgcn_mfma_f32_16x16x32_bf16(Bt[n][k], At[m][k], acc[ai][bj][m][n], 0, 0, 0); __builtin_amdgcn_s_setprio(0); } while (0)
#define PG8_WAIT_V(n) asm volatile("s_waitcnt vmcnt(" #n ")" ::: "memory")
#define PG8_WAIT_L(n) asm volatile("s_waitcnt lgkmcnt(" #n ")" ::: "memory")
#define PG8_BAR __builtin_amdgcn_s_barrier()
#define PG8_SCHED __builtin_amdgcn_sched_barrier(0)
    Unit cur, nxt; int ui = 0;
    if (!S.next(0, cur)) return;
    f32x4 acc[2][2][4][2];
#pragma unroll
    for (int a = 0; a < 2; ++a)
#pragma unroll
        for (int b = 0; b < 2; ++b)
#pragma unroll
            for (int m = 0; m < 4; ++m)
#pragma unroll
                for (int n = 0; n < 2; ++n) acc[a][b][m][n] = (f32x4){0.f, 0.f, 0.f, 0.f};
    bf16x8 At[4][2], B0[2][2], B1[2][2];
    const char* cA = (const char*)g.A + (size_t)cur.pm * tstep; const char* cB = (const char*)g.Bt + (size_t)cur.pn * tstep;
    S.a_ready(cur);
    if constexpr (SP2) {
        PG8_STAGE(PG8_SB(0, 0), cB, voffB); PG8_STAGE(PG8_SB(0, 1), cB + hstep, voffB); PG8_STAGE(PG8_SA(0, 0), cA, voffA); PG8_STAGE(PG8_SA(0, 1), cA + hstep, voffA);
        if (wr == 1) PG8_BAR;
        PG8_WAIT_V(2); PG8_BAR;
        PG8_STAGE(PG8_SB(1, 0), cB + kstep, voffB); PG8_STAGE(PG8_SA(1, 0), cA + kstep, voffA); PG8_STAGE(PG8_SB(1, 1), cB + hstep + kstep, voffB);
        PG8_WAIT_V(6); PG8_BAR;
    } else {
        PG8_STAGE(PG8_SB(0, 0), cB, voffB); PG8_STAGE(PG8_SA(0, 0), cA, voffA); PG8_STAGE(PG8_SB(0, 1), cB + hstep, voffB); PG8_STAGE(PG8_SA(0, 1), cA + hstep, voffA);
        if (wr == 1) PG8_BAR;
        PG8_WAIT_V(4); PG8_BAR;
        PG8_STAGE(PG8_SB(1, 0), cB + kstep, voffB); PG8_STAGE(PG8_SA(1, 0), cA + kstep, voffA); PG8_STAGE(PG8_SB(1, 1), cB + hstep + kstep, voffB);
        PG8_WAIT_V(6); PG8_BAR;
    }
    for (;;) {
        const bool has_next = S.next(ui + 1, nxt);
        const char* nA = has_next ? (const char*)g.A + (size_t)nxt.pm * tstep : cA; const char* nB = has_next ? (const char*)g.Bt + (size_t)nxt.pn * tstep : cB;
        for (int t = 0; t < nt; t += 2) {
            const bool last = (t == nt - 2);
            const char* a1 = cA + (size_t)(t + 1) * kstep;
            const char* a2 = last ? nA : cA + (size_t)(t + 2) * kstep; const char* b2 = last ? nB : cB + (size_t)(t + 2) * kstep;
            const char* a3 = a2 + kstep; const char* b3 = b2 + kstep;
            if (last && has_next) S.a_ready(nxt);
            if constexpr (SP2) {
            PG8_LDB(B0, 0, 0); PG8_LDB(B1, 0, 1); PG8_SCHED; PG8_LDA(At, 0, 0); PG8_STAGE(PG8_SA(1, 1), a1 + hstep, voffA);
            PG8_WAIT_V(8); PG8_WAIT_L(0); PG8_BAR; PG8_MMA(0, 0, At, B0); PG8_MMA(0, 1, At, B1); PG8_BAR; PG8_SCHED;
            PG8_LDA(At, 0, 1); PG8_STAGE(PG8_SB(0, 0), b2, voffB); PG8_STAGE(PG8_SB(0, 1), b2 + hstep, voffB); PG8_STAGE(PG8_SA(0, 0), a2, voffA);
            PG8_WAIT_V(8); PG8_WAIT_L(0); PG8_BAR; PG8_MMA(1, 0, At, B0); PG8_MMA(1, 1, At, B1); PG8_BAR; PG8_SCHED;
            PG8_LDB(B0, 1, 0); PG8_LDB(B1, 1, 1); PG8_SCHED; PG8_LDA(At, 1, 0); PG8_STAGE(PG8_SA(0, 1), a2 + hstep, voffA);
            PG8_WAIT_V(8); PG8_WAIT_L(0); PG8_BAR; PG8_MMA(0, 0, At, B0); PG8_MMA(0, 1, At, B1); PG8_BAR; PG8_SCHED;
            PG8_LDA(At, 1, 1); PG8_STAGE(PG8_SB(1, 0), b3, voffB); PG8_STAGE(PG8_SB(1, 1), b3 + hstep, voffB); PG8_STAGE(PG8_SA(1, 0), a3, voffA);
            PG8_WAIT_V(8); PG8_WAIT_L(0); PG8_BAR; PG8_MMA(1, 0, At, B0); PG8_MMA(1, 1, At, B1); PG8_BAR; PG8_SCHED;
            } else {
            PG8_LDB(B0, 0, 0); PG8_SCHED; PG8_LDA(At, 0, 0); PG8_STAGE(PG8_SA(1, 1), a1 + hstep, voffA);
            PG8_WAIT_L(8); PG8_BAR; PG8_WAIT_L(0); PG8_MMA(0, 0, At, B0); PG8_BAR; PG8_SCHED;
            PG8_LDB(B1, 0, 1); PG8_STAGE(PG8_SB(0, 0), b2, voffB);
            PG8_BAR; PG8_WAIT_L(0); PG8_MMA(0, 1, At, B1); PG8_BAR;
            PG8_LDA(At, 0, 1); PG8_STAGE(PG8_SA(0, 0), a2, voffA);
            PG8_BAR; PG8_WAIT_L(0); PG8_MMA(1, 0, At, B0); PG8_BAR; PG8_SCHED;
            PG8_STAGE(PG8_SB(0, 1), b2 + hstep, voffB);
            PG8_WAIT_V(6); PG8_BAR; PG8_MMA(1, 1, At, B1); PG8_BAR;
            PG8_LDB(B0, 1, 0); PG8_SCHED; PG8_LDA(At, 1, 0); PG8_STAGE(PG8_SA(0, 1), a2 + hstep, voffA);
            PG8_WAIT_L(8); PG8_BAR; PG8_WAIT_L(0); PG8_MMA(0, 0, At, B0); PG8_BAR; PG8_SCHED;
            PG8_LDB(B1, 1, 1); PG8_STAGE(PG8_SB(1, 0), b3, voffB);
            PG8_BAR; PG8_WAIT_L(0); PG8_MMA(0, 1, At, B1); PG8_BAR;
            PG8_LDA(At, 1, 1); PG8_STAGE(PG8_SA(1, 0), a3, voffA);
            PG8_BAR; PG8_WAIT_L(0); PG8_MMA(1, 0, At, B0); PG8_BAR; PG8_SCHED;
            PG8_STAGE(PG8_SB(1, 1), b3 + hstep, voffB);
            PG8_WAIT_V(6); PG8_BAR; PG8_MMA(1, 1, At, B1); PG8_BAR;
            }
        }
        if constexpr (ALIGN_EPI) { if (wr == 0) PG8_BAR; }
        if constexpr (!Epi::AFTER_DRAIN) { E(acc, cur, wr, wc, fr, fq); S.done(cur); }
        if (!has_next) break;
#pragma unroll
        for (int a = 0; a < 2; ++a)
#pragma unroll
            for (int b = 0; b < 2; ++b)
#pragma unroll
                for (int m = 0; m < 4; ++m)
#pragma unroll
                    for (int n = 0; n < 2; ++n) acc[a][b][m][n] = (f32x4){0.f, 0.f, 0.f, 0.f};
        cur = nxt; cA = nA; cB = nB; ++ui;
        if constexpr (ALIGN_EPI) { if (wr == 1) PG8_BAR; }
    }
    PG8_WAIT_V(0);
    if constexpr (!ALIGN_EPI) { if (wr == 0) PG8_BAR; }
    PG8_BAR;
    if constexpr (Epi::AFTER_DRAIN) { E.fused(acc, cur, wr, wc, fr, fq, lds, wid, lane); S.done(cur); }
#undef PG8_SA
#undef PG8_SB
#undef PG8_STAGE
#undef PG8_LDA
#undef PG8_LDB
#undef PG8_MMA
#undef PG8_WAIT_V
#undef PG8_WAIT_L
#undef PG8_BAR
#undef PG8_SCHED
}
}
#ifndef PG8_SP2
#define PG8_SP2 true
#endif
#ifndef PG8_ALIGN
#define PG8_ALIGN true
#endif

#define LAS __attribute__((address_space(3)))
typedef unsigned short bf16_t;
typedef short bf16x8 __attribute__((ext_vector_type(8)));
typedef float f32x4 __attribute__((ext_vector_type(4)));
typedef float f32x16 __attribute__((ext_vector_type(16)));
typedef unsigned u32x4 __attribute__((ext_vector_type(4)));
typedef unsigned u32x2 __attribute__((ext_vector_type(2)));
constexpr int NB = 16, T = 2048, D = 1024, MR = NB * T, MP = 33024, META0 = 32768;
constexpr int DFF = 2816, NUP = 5632;
constexpr float EPS = 1e-6f, LOG2E = 1.4426950408889634f;
constexpr size_t MiB = 1u << 20;
constexpr size_t WS_XB = 0;
constexpr size_t WS_WIN = (size_t)MP * D * 2;
constexpr size_t WS_WOUT = 71 * MiB;
constexpr size_t WS_WUP = 73 * MiB;
constexpr size_t WS_ACT = 0;
constexpr size_t WS_WDN = 90 * MiB;
constexpr size_t WS_PART1 = 96 * MiB, WS_PART2 = 99 * MiB, WS_RSTD1 = 101 * MiB;
constexpr size_t WS_R = 102 * MiB;
constexpr size_t QK_STRIDE = (size_t)MP * 512;
constexpr size_t WS_QK = WS_R, WS_VT = WS_R + 4 * QK_STRIDE * 2, WS_MRG = WS_VT + (size_t)1024 * MP * 2;
constexpr size_t WS_END = WS_R + (size_t)MP * NUP * 2;
static_assert(WS_WIN + (size_t)3072 * D * 2 <= WS_WOUT && WS_MRG + (size_t)MP * D * 2 <= WS_END && (size_t)16384 * DFF * 2 <= WS_WDN, "ws map");
constexpr int LDS_BYTES = 147456;
constexpr int NTHREADS = 512;

__device__ __forceinline__ unsigned cvtpk(float lo, float hi) { typedef float f2 __attribute__((ext_vector_type(2))); typedef __bf16 b2 __attribute__((ext_vector_type(2))); f2 v = {lo, hi}; b2 b = __builtin_convertvector(v, b2); return __builtin_bit_cast(unsigned, b); }
__device__ __forceinline__ float wave_sum(float v) {
#pragma unroll
    for (int o = 1; o < 64; o <<= 1) v += __shfl_xor(v, o);
    return v;
}
#define LDS_WAIT() asm volatile("s_waitcnt lgkmcnt(0)" ::: "memory")

template <int MODE> __device__ __forceinline__ void transpose_item(const float* W, int K, int N, bf16_t* WT, LAS float* scr, int item, int lane, const float* g0, const float* g1) {
    const int nblk = N / 32, kb = item / nblk, nb = item % nblk, k0 = 64 * kb, n0 = 32 * nb;
#pragma unroll 8
    for (int i = 0; i < 32; ++i) { const int kk = 2 * i + (lane >> 5), k = k0 + kk; float s = 1.f;
        if (MODE == 1 || MODE == 3) s = g0[k];
        if (MODE == 2) s = k < 512 ? g0[k & 127] * 0.8f : g1[(k - 512) & 63];
        scr[kk * 33 + (lane & 31)] = W[(size_t)k * N + n0 + (lane & 31)] * s; }
    LDS_WAIT(); asm volatile("" ::: "memory");
    int d0 = n0;
    if (MODE == 1) { const int seg = n0 >> 9; const int ns = seg == 2 ? 4 : (seg == 3 ? 2 : (seg == 4 ? 3 : seg)); d0 = ns * 512 + (n0 & 511); }
    const int c = lane & 7;
#pragma unroll
    for (int j = 0; j < 4; ++j) { const int n = (lane >> 3) + 8 * j; const LAS float* s = scr + (8 * c) * 33 + n;
        u32x4 o; o.x = cvtpk(s[0 * 33], s[1 * 33]); o.y = cvtpk(s[2 * 33], s[3 * 33]); o.z = cvtpk(s[4 * 33], s[5 * 33]); o.w = cvtpk(s[6 * 33], s[7 * 33]);
        *(u32x4*)(WT + (size_t)(d0 + n) * K + k0 + 8 * c) = o; }
    LDS_WAIT(); asm volatile("" ::: "memory");
}
__device__ __forceinline__ void rms_row_to_bf16(const float* xrow, bf16_t* orow, int lane) {
    const f32x4* xr = (const f32x4*)xrow + lane;
    f32x4 v[4]; float s = 0.f;
#pragma unroll
    for (int j = 0; j < 4; ++j) { v[j] = xr[64 * j]; s += (v[j].x * v[j].x + v[j].y * v[j].y) + (v[j].z * v[j].z + v[j].w * v[j].w); }
    const float rs = rsqrtf(wave_sum(s) * (1.f / D) + EPS);
    u32x2* o8 = (u32x2*)orow + lane;
#pragma unroll
    for (int j = 0; j < 4; ++j) { u32x2 w; w.x = cvtpk(v[j].x * rs, v[j].y * rs); w.y = cvtpk(v[j].z * rs, v[j].w * rs); o8[64 * j] = w; }
}

constexpr int KROW = 144;
constexpr int DF_K1 = 0, DF_K2 = 64 * KROW, DF_V = 2 * 64 * KROW, DF_BUF = DF_V + 128 * KROW;
constexpr int SB_K = 0, SB_V = 64 * KROW, SB_BUF = 2 * 64 * KROW;
__device__ __forceinline__ int pi32(int r) { return (r & 0x13) | ((r & 4) << 1) | ((r & 8) >> 1); }
__device__ __forceinline__ bf16x8 pack_frag(float a0, float a1, float a2, float a3, float a4, float a5, float a6, float a7) {
    u32x4 w; w.x = cvtpk(a0, a1); w.y = cvtpk(a2, a3); w.z = cvtpk(a4, a5); w.w = cvtpk(a6, a7); return __builtin_bit_cast(bf16x8, w); }
#define MFMA32(a, b, c) __builtin_amdgcn_mfma_f32_32x32x16_bf16(a, b, c, 0, 0, 0)

__device__ __forceinline__ void diff_unit(LAS unsigned char* lds, const bf16_t* Qd, const bf16_t* Kd, const bf16_t* Vt, bf16_t* merged,
                                          int h, int krow_real, int qrow0, int qpos0, int kt_hi, int nvalid, float cs, float lam, int tid) {
    const int lane = tid & 63, wid = __builtin_amdgcn_readfirstlane(tid >> 6), map = wid >> 2, wq = wid & 3, ql = lane & 31, hl = lane >> 5;
    const int skey = tid >> 3, sch = tid & 7;
    const bf16_t* gK = Kd + (size_t)skey * 512 + h * 128 + sch * 8;
    const bf16_t* gV = Vt + (size_t)(h * 128 + skey) * MP + sch * 8;
    const int sK = skey * KROW + sch * 16;
    u32x4 rk1, rk2, rv0, rv1;
#define DF_LOAD(kt_) do { const int krow_ = (kt_) == 0 ? META0 - 48 : krow_real + 64 * ((kt_) - 1); rk1 = *(const u32x4*)(gK + (size_t)krow_ * 512); rk2 = *(const u32x4*)(gK + (size_t)krow_ * 512 + 64); \
        rv0 = *(const u32x4*)(gV + krow_); rv1 = *(const u32x4*)(gV + krow_ + (size_t)64 * MP); } while (0)
#define DF_STORE(b_) do { LAS unsigned char* d_ = lds + (b_) * DF_BUF + sK; *(LAS u32x4*)(d_ + DF_K1) = rk1; *(LAS u32x4*)(d_ + DF_K2) = rk2; *(LAS u32x4*)(d_ + DF_V) = rv0; *(LAS u32x4*)(d_ + DF_V + 64 * KROW) = rv1; } while (0)
    const int qrow = qrow0 + 32 * wq + ql, qpos = qpos0 + 32 * wq + ql, qw = qpos0 + 32 * wq;
    bf16x8 qf[4];
#pragma unroll
    for (int ks = 0; ks < 4; ++ks) qf[ks] = *(const bf16x8*)(Qd + (size_t)qrow * 512 + h * 128 + map * 64 + 16 * ks + 8 * hl);
    f32x16 o[4];
#pragma unroll
    for (int et = 0; et < 4; ++et)
#pragma unroll
        for (int r = 0; r < 16; ++r) o[et][r] = 0.f;
    float m = -INFINITY, l = 0.f;
    const int kaddr = (map ? DF_K2 : DF_K1) + pi32(ql) * KROW + 16 * hl;
    const int vaddr = DF_V + ql * KROW + 16 * hl;
    DF_LOAD(kt_hi); DF_STORE(0); __syncthreads();
    int buf = 0;
    for (int kt = kt_hi; kt >= 0; --kt) {
        if (kt > 0) DF_LOAD(kt - 1);
        const bool skip = (kt > 0) && (64 * kt - 48 > qw + 31);
        if (!skip) {
            const bool full = (kt > 0) && (64 * kt + 15 <= qw);
            const LAS unsigned char* Lb = lds + buf * DF_BUF;
            f32x16 sc[2];
            const float kb = cs * (float)(64 * kt - 48 + 8 * hl);
#pragma unroll
            for (int c = 0; c < 2; ++c)
#pragma unroll
                for (int r = 0; r < 16; ++r) sc[c][r] = __builtin_fmaf(cs, (float)(32 * c + 16 * (r >> 3) + (r & 7)), kb);
#pragma unroll
            for (int c = 0; c < 2; ++c)
#pragma unroll
                for (int ks = 0; ks < 4; ++ks) { const bf16x8 kf = *(const LAS bf16x8*)(Lb + kaddr + c * 32 * KROW + ks * 32); sc[c] = MFMA32(kf, qf[ks], sc[c]); }
            if (!full) {
                const int kp0 = 64 * kt - 48 + 8 * hl;
#pragma unroll
                for (int c = 0; c < 2; ++c)
#pragma unroll
                    for (int r = 0; r < 16; ++r) { const int kpos = kp0 + 32 * c + 16 * (r >> 3) + (r & 7); if (!(kpos >= 0 && kpos <= qpos)) sc[c][r] = -INFINITY; }
            }
            float mx = sc[0][0];
#pragma unroll
            for (int r = 1; r < 16; ++r) mx = fmaxf(mx, sc[0][r]);
#pragma unroll
            for (int r = 0; r < 16; ++r) mx = fmaxf(mx, sc[1][r]);
            mx = fmaxf(mx, __shfl_xor(mx, 32));
            if (__any(mx > m + 8.f)) {
                const float mn = fmaxf(m, mx); const float al = (m == -INFINITY) ? 0.f : __builtin_amdgcn_exp2f(m - mn);
                l *= al;
#pragma unroll
                for (int et = 0; et < 4; ++et)
#pragma unroll
                    for (int r = 0; r < 16; ++r) o[et][r] *= al;
                m = mn;
            }
            const float mref = (m == -INFINITY) ? 0.f : m;
            float ls = 0.f;
#pragma unroll
            for (int c = 0; c < 2; ++c)
#pragma unroll
                for (int r = 0; r < 16; ++r) { sc[c][r] = __builtin_amdgcn_exp2f(sc[c][r] - mref); ls += sc[c][r]; }
            l += ls;
            bf16x8 pf[2][2];
#pragma unroll
            for (int c = 0; c < 2; ++c)
#pragma unroll
                for (int s = 0; s < 2; ++s) pf[c][s] = pack_frag(sc[c][8 * s], sc[c][8 * s + 1], sc[c][8 * s + 2], sc[c][8 * s + 3], sc[c][8 * s + 4], sc[c][8 * s + 5], sc[c][8 * s + 6], sc[c][8 * s + 7]);
#pragma unroll
            for (int et = 0; et < 4; ++et)
#pragma unroll
                for (int c = 0; c < 2; ++c)
#pragma unroll
                    for (int s = 0; s < 2; ++s) { const bf16x8 vf = *(const LAS bf16x8*)(Lb + vaddr + et * 32 * KROW + c * 64 + s * 32); o[et] = MFMA32(vf, pf[c][s], o[et]); }
        }
        if (kt > 0) DF_STORE(buf ^ 1);
        __syncthreads();
        buf ^= 1;
    }
#undef DF_LOAD
#undef DF_STORE
    l += __shfl_xor(l, 32);
    const float inv = 1.f / l;
    LAS float* xch = (LAS float*)lds + wq * 4096 + lane;
    if (map == 1) { const float f = lam * inv;
#pragma unroll
        for (int et = 0; et < 4; ++et)
#pragma unroll
            for (int r = 0; r < 16; ++r) xch[(et * 16 + r) * 64] = o[et][r] * f; }
    __syncthreads();
    if (map == 0) {
        float ss = 0.f;
#pragma unroll
        for (int et = 0; et < 4; ++et)
#pragma unroll
            for (int r = 0; r < 16; ++r) { const float v = o[et][r] * inv - xch[(et * 16 + r) * 64]; o[et][r] = v; ss += v * v; }
        ss += __shfl_xor(ss, 32);
        const float rs = rsqrtf(ss * (1.f / 128.f) + EPS);
        if (32 * wq + ql < nvalid) {
            bf16_t* op = merged + (size_t)qrow * 1024 + h * 128 + 4 * hl;
#pragma unroll
            for (int et = 0; et < 4; ++et)
#pragma unroll
                for (int g = 0; g < 4; ++g) { u32x2 w; w.x = cvtpk(o[et][4 * g] * rs, o[et][4 * g + 1] * rs); w.y = cvtpk(o[et][4 * g + 2] * rs, o[et][4 * g + 3] * rs); *(u32x2*)(op + 32 * et + 8 * g) = w; }
        }
    }
    __syncthreads();
}

__device__ __forceinline__ void sb_unit(LAS unsigned char* lds, const bf16_t* Qs, const bf16_t* Ks, const bf16_t* Vt, bf16_t* merged,
                                        int h, int krow_real, int qrow0, int qpos0, int kt_hi, int nvalid, int tid) {
    const int lane = tid & 63, wid = __builtin_amdgcn_readfirstlane(tid >> 6), ql = lane & 31, hl = lane >> 5;
    const int skey = tid >> 3, sch = tid & 7;
    const bf16_t* gK = Ks + (size_t)skey * 512 + h * 64 + sch * 8;
    const bf16_t* gV = Vt + (size_t)(512 + h * 64 + skey) * MP + sch * 8;
    const int sK = skey * KROW + sch * 16;
    u32x4 rk, rv;
#define SB_LOAD(kt_) do { const int krow_ = (kt_) == 0 ? META0 - 48 : krow_real + 64 * ((kt_) - 1); rk = *(const u32x4*)(gK + (size_t)krow_ * 512); rv = *(const u32x4*)(gV + krow_); } while (0)
#define SB_STORE(b_) do { LAS unsigned char* d_ = lds + (b_) * SB_BUF + sK; *(LAS u32x4*)(d_ + SB_K) = rk; *(LAS u32x4*)(d_ + SB_V) = rv; } while (0)
    const int qrow = qrow0 + 32 * wid + ql, qpos = qpos0 + 32 * wid + ql, qw = qpos0 + 32 * wid;
    bf16x8 qf[4];
#pragma unroll
    for (int ks = 0; ks < 4; ++ks) qf[ks] = *(const bf16x8*)(Qs + (size_t)qrow * 512 + h * 64 + 16 * ks + 8 * hl);
    f32x16 o[2];
#pragma unroll
    for (int et = 0; et < 2; ++et)
#pragma unroll
        for (int r = 0; r < 16; ++r) o[et][r] = 0.f;
    float R = 1.f;
    const int kaddr = SB_K + pi32(ql) * KROW + 16 * hl;
    const int vaddr = SB_V + ql * KROW + 16 * hl;
    SB_LOAD(kt_hi); SB_STORE(0); __syncthreads();
    int buf = 0;
    for (int kt = kt_hi; kt >= 0; --kt) {
        if (kt > 0) SB_LOAD(kt - 1);
        const bool skip = (kt > 0) && (64 * kt - 48 >= qw + 31);
        if (!skip) {
            const bool full = (kt > 0) && (64 * kt + 15 < qw);
            const LAS unsigned char* Lb = lds + buf * SB_BUF;
            f32x16 sc[2];
#pragma unroll
            for (int c = 0; c < 2; ++c) {
#pragma unroll
                for (int r = 0; r < 16; ++r) sc[c][r] = 0.f;
#pragma unroll
                for (int ks = 0; ks < 4; ++ks) { const bf16x8 kf = *(const LAS bf16x8*)(Lb + kaddr + c * 32 * KROW + ks * 32); sc[c] = MFMA32(kf, qf[ks], sc[c]); }
            }
            bf16x8 pf[2][2];
            const int kp0 = 64 * kt - 48 + 8 * hl;
#pragma unroll
            for (int c = 1; c >= 0; --c)
#pragma unroll
                for (int s = 1; s >= 0; --s) {
                    float sg[8], ci[8];
#pragma unroll
                    for (int j = 0; j < 8; ++j) { float u = __builtin_amdgcn_exp2f(fminf(sc[c][8 * s + j], 100.f));
                        if (!full) { const int kpos = kp0 + 32 * c + 16 * s + j; if (!(kpos >= 0 && kpos < qpos)) u = 0.f; }
                        ci[j] = __builtin_amdgcn_rcpf(1.f + u); sg[j] = u * ci[j]; }
                    float e = 1.f;
#pragma unroll
                    for (int j = 7; j >= 0; --j) { sg[j] *= e; e *= ci[j]; }
                    const float ep = __shfl_xor(e, 32);
                    const float F = R * (hl ? 1.f : ep);
                    R *= e * ep;
                    pf[c][s] = pack_frag(sg[0] * F, sg[1] * F, sg[2] * F, sg[3] * F, sg[4] * F, sg[5] * F, sg[6] * F, sg[7] * F);
                }
#pragma unroll
            for (int et = 0; et < 2; ++et)
#pragma unroll
                for (int c = 0; c < 2; ++c)
#pragma unroll
                    for (int s = 0; s < 2; ++s) { const bf16x8 vf = *(const LAS bf16x8*)(Lb + vaddr + et * 32 * KROW + c * 64 + s * 32); o[et] = MFMA32(vf, pf[c][s], o[et]); }
        }
        if (kt > 0) SB_STORE(buf ^ 1);
        __syncthreads();
        buf ^= 1;
    }
#undef SB_LOAD
#undef SB_STORE
    float ss = 0.f;
#pragma unroll
    for (int et = 0; et < 2; ++et)
#pragma unroll
        for (int r = 0; r < 16; ++r) ss += o[et][r] * o[et][r];
    ss += __shfl_xor(ss, 32);
    const float rs = rsqrtf(ss * (1.f / 64.f) + EPS);
    if (32 * wid + ql < nvalid) {
        bf16_t* op = merged + (size_t)qrow * 1024 + 512 + h * 64 + 4 * hl;
#pragma unroll
        for (int et = 0; et < 2; ++et)
#pragma unroll
            for (int g = 0; g < 4; ++g) { u32x2 w; w.x = cvtpk(o[et][4 * g] * rs, o[et][4 * g + 1] * rs); w.y = cvtpk(o[et][4 * g + 2] * rs, o[et][4 * g + 3] * rs); *(u32x2*)(op + 32 * et + 8 * g) = w; }
    }
}

__device__ __forceinline__ void conv_phase(const bf16_t* hup, const float* rstd1, const float* cw, const float* cb, bf16_t* act, int half, int gtid, int nthreads) {
    for (int item = gtid; item < 1024 * 352; item += nthreads) {
        const int rg = item / 352, c = (item - rg * 352) * 8, r0 = half * 16384 + rg * 16, t0 = r0 & 2047;
        float w[2][3][8], bb[2][8];
#pragma unroll
        for (int z = 0; z < 2; ++z) {
#pragma unroll
            for (int k = 0; k < 3; ++k) { const f32x4 a = *(const f32x4*)(cw + (size_t)k * NUP + z * DFF + c), b = *(const f32x4*)(cw + (size_t)k * NUP + z * DFF + c + 4);
                w[z][k][0] = a[0]; w[z][k][1] = a[1]; w[z][k][2] = a[2]; w[z][k][3] = a[3]; w[z][k][4] = b[0]; w[z][k][5] = b[1]; w[z][k][6] = b[2]; w[z][k][7] = b[3]; }
            const f32x4 a = *(const f32x4*)(cb + z * DFF + c), b = *(const f32x4*)(cb + z * DFF + c + 4);
            bb[z][0] = a[0]; bb[z][1] = a[1]; bb[z][2] = a[2]; bb[z][3] = a[3]; bb[z][4] = b[0]; bb[z][5] = b[1]; bb[z][6] = b[2]; bb[z][7] = b[3];
        }
        float A[2][8], B[2][8], C[2][8];
#define CV_LOAD(dst, row_) do { const int rr_ = (row_); const float s_ = rstd1[rr_]; _Pragma("unroll") for (int z = 0; z < 2; ++z) { const u32x4 q_ = *(const u32x4*)(hup + (size_t)rr_ * NUP + z * DFF + c); \
            dst[z][0] = __builtin_bit_cast(float, q_.x << 16) * s_; dst[z][1] = __builtin_bit_cast(float, q_.x & 0xffff0000u) * s_; dst[z][2] = __builtin_bit_cast(float, q_.y << 16) * s_; dst[z][3] = __builtin_bit_cast(float, q_.y & 0xffff0000u) * s_; \
            dst[z][4] = __builtin_bit_cast(float, q_.z << 16) * s_; dst[z][5] = __builtin_bit_cast(float, q_.z & 0xffff0000u) * s_; dst[z][6] = __builtin_bit_cast(float, q_.w << 16) * s_; dst[z][7] = __builtin_bit_cast(float, q_.w & 0xffff0000u) * s_; } } while (0)
        CV_LOAD(A, t0 ? r0 - 2 : META0 + 14);
        CV_LOAD(B, t0 ? r0 - 1 : META0 + 15);
        for (int i = 0; i < 16; ++i) {
            const int r = r0 + i;
            CV_LOAD(C, r);
            float ov[8];
#pragma unroll
            for (int j = 0; j < 8; ++j) {
                const float g = bb[0][j] + w[0][0][j] * A[0][j] + w[0][1][j] * B[0][j] + w[0][2][j] * C[0][j];
                const float u = bb[1][j] + w[1][0][j] * A[1][j] + w[1][1][j] * B[1][j] + w[1][2][j] * C[1][j];
                ov[j] = g * __builtin_amdgcn_rcpf(1.f + __builtin_amdgcn_exp2f(-LOG2E * g)) * u;
            }
            u32x4 q; q.x = cvtpk(ov[0], ov[1]); q.y = cvtpk(ov[2], ov[3]); q.z = cvtpk(ov[4], ov[5]); q.w = cvtpk(ov[6], ov[7]);
            *(u32x4*)(act + (size_t)(r - half * 16384) * DFF + c) = q;
#pragma unroll
            for (int z = 0; z < 2; ++z)
#pragma unroll
                for (int j = 0; j < 8; ++j) { A[z][j] = B[z][j]; B[z][j] = C[z][j]; }
        }
#undef CV_LOAD
    }
}

struct Args { const float* in[17]; float* out; unsigned char* ws; };
__global__ void __launch_bounds__(NTHREADS, 2) hymba_fwd(Args args) {
    extern __shared__ __attribute__((aligned(16))) unsigned char lds_raw[];
    LAS unsigned char* lds = (LAS unsigned char*)lds_raw;
    cg::grid_group grid = cg::this_grid();
    const int tid = threadIdx.x, lane = tid & 63, wave = __builtin_amdgcn_readfirstlane(tid >> 6);
    const int G = gridDim.x, bx = blockIdx.x;
    const int vcu = (G % 8 == 0) ? (bx % 8) * (G / 8) + bx / 8 : bx;
    unsigned char* ws = args.ws;
    bf16_t* XB = (bf16_t*)(ws + WS_XB); bf16_t* WIN = (bf16_t*)(ws + WS_WIN); bf16_t* WOUT = (bf16_t*)(ws + WS_WOUT); bf16_t* WUP = (bf16_t*)(ws + WS_WUP); bf16_t* WDN = (bf16_t*)(ws + WS_WDN);
    bf16_t* QK = (bf16_t*)(ws + WS_QK); bf16_t* VT = (bf16_t*)(ws + WS_VT); bf16_t* MRG = (bf16_t*)(ws + WS_MRG); bf16_t* HUP = (bf16_t*)(ws + WS_R); bf16_t* ACT = (bf16_t*)(ws + WS_ACT);
    float* PART1 = (float*)(ws + WS_PART1); float* PART2 = (float*)(ws + WS_PART2); float* RSTD1 = (float*)(ws + WS_RSTD1);
    float* OUT = args.out;

#ifndef NO_P0
    {
        LAS float* scr = (LAS float*)(lds + wave * 16384);
        const int gw = vcu * 8 + wave, NGW = G * 8;
        constexpr int I_IN = 16 * 96, I_OUT = 16 * 32, I_UP = 16 * 176, I_DN = 44 * 32;
        for (int it = gw; it < I_IN + I_OUT + I_UP + I_DN; it += NGW) {
            int r = it;
            if (r < I_IN) { transpose_item<1>(args.in[3], 1024, 3072, WIN, scr, r, lane, args.in[2], nullptr); continue; } r -= I_IN;
            if (r < I_OUT) { transpose_item<2>(args.in[10], 1024, 1024, WOUT, scr, r, lane, args.in[8], args.in[9]); continue; } r -= I_OUT;
            if (r < I_UP) { transpose_item<3>(args.in[12], 1024, NUP, WUP, scr, r, lane, args.in[11], nullptr); continue; } r -= I_UP;
            transpose_item<0>(args.in[15], DFF, 1024, WDN, scr, r, lane, nullptr, nullptr);
        }
        for (int mrow = gw; mrow < MP; mrow += NGW) {
            if (mrow < META0 + 16) rms_row_to_bf16(mrow < META0 ? args.in[0] + (size_t)mrow * D : args.in[1] + (size_t)(mrow - META0) * D, XB + (size_t)mrow * D, lane);
            else { u32x4 z = {0u, 0u, 0u, 0u}; ((u32x4*)(XB + (size_t)mrow * D))[lane] = z; ((u32x4*)(XB + (size_t)mrow * D))[lane + 64] = z;
                   ((u32x4*)(MRG + (size_t)mrow * D))[lane] = z; ((u32x4*)(MRG + (size_t)mrow * D))[lane + 64] = z; }
        }
    }
    grid.sync();

#endif
#ifndef NO_P1
    {
        pg8::Gemm g{XB, XB, MP + 3072, MP + 3072, D};
        pg8::OrderInProj S{G, bx};
        pg8::EpiInProj E{QK, QK_STRIDE, VT, MP, 0.125f * LOG2E};
        pg8::gemm_phase<pg8::EpiInProj, pg8::OrderInProj, PG8_ALIGN, PG8_SP2>(lds, g, S, E);
    }
    grid.sync();

#endif
#ifndef NO_P2
    {
        int tid2 = threadIdx.x; asm volatile("" : "+v"(tid2)); const int lane2 = tid2 & 63;
        const float s1 = wave_sum(args.in[4][lane2] * args.in[5][lane2]), s2 = wave_sum(args.in[6][lane2] * args.in[7][lane2]);
        const float lam = expf(s1) - expf(s2) + 0.2f;
        const bf16_t* Qd = QK; const bf16_t* Kd = QK + QK_STRIDE; const bf16_t* Qs = QK + 2 * QK_STRIDE; const bf16_t* Ks = QK + 3 * QK_STRIDE;
        for (int p = vcu; p < 516; p += G) {
            if (p < 512) { const int b = p >> 5, h = (p >> 3) & 3, ip = p & 7; const float cs = exp2f(-2.f * (float)(h + 1)) * LOG2E;
                for (int hf = 0; hf < 2; ++hf) { const int i = hf ? ip : 15 - ip; diff_unit(lds, Qd, Kd, VT, MRG, h, b * T, b * T + 128 * i, 16 + 128 * i, 2 * i + 2, 128, cs, lam, tid2); } }
            else { const int h = p - 512; const float cs = exp2f(-2.f * (float)(h + 1)) * LOG2E; diff_unit(lds, Qd, Kd, VT, MRG, h, 0, META0, 0, 0, 16, cs, lam, tid2); }
        }
        for (int p = vcu; p < 520; p += G) {
            if (p < 512) { const int b = p >> 5, h = (p >> 2) & 7, ip = p & 3;
                for (int hf = 0; hf < 2; ++hf) { const int i = hf ? ip : 7 - ip; sb_unit(lds, Qs, Ks, VT, MRG, h, b * T, b * T + 256 * i, 16 + 256 * i, 4 * i + 4, 256, tid2); } }
            else { const int h = p - 512; sb_unit(lds, Qs, Ks, VT, MRG, h, 0, META0, 0, 0, 16, tid2); }
        }
    }
    grid.sync();

#endif
#ifndef NO_P3
    {
        pg8::Gemm g{MRG, WOUT, MP, D, D}; pg8::StaticOrder S; S.init(MP, D, G, bx);
        pg8::EpiRes1 E{args.in[0], args.in[1], OUT, XB, PART1};
        pg8::gemm_phase<pg8::EpiRes1, pg8::StaticOrder, PG8_ALIGN, PG8_SP2>(lds, g, S, E);
    }
    grid.sync();

#endif
#ifndef NO_P4
    {
        int tid4 = threadIdx.x; asm volatile("" : "+v"(tid4));
        for (int r = bx * NTHREADS + tid4; r < MP; r += G * NTHREADS) { const f32x4* p4 = (const f32x4*)(PART1 + (size_t)r * 16); const f32x4 a = p4[0], b = p4[1], c = p4[2], d = p4[3];
            const float ss = ((a[0] + a[1]) + (a[2] + a[3])) + ((b[0] + b[1]) + (b[2] + b[3])) + ((c[0] + c[1]) + (c[2] + c[3])) + ((d[0] + d[1]) + (d[2] + d[3]));
            RSTD1[r] = rsqrtf(ss * (1.f / D) + EPS); }
        pg8::Gemm g{XB, WUP, MP, NUP, D}; pg8::StaticOrder S; S.init(MP, NUP, G, bx);
        pg8::EpiPlain E{HUP, NUP};
        pg8::gemm_phase<pg8::EpiPlain, pg8::StaticOrder, PG8_ALIGN, PG8_SP2>(lds, g, S, E);
    }
    grid.sync();

#endif
#ifndef NO_P5
    for (int half = 0; half < 2; ++half) {
        { int tid5 = threadIdx.x; asm volatile("" : "+v"(tid5)); conv_phase(HUP, RSTD1, args.in[13], args.in[14], ACT, half, bx * NTHREADS + tid5, G * NTHREADS); }
        grid.sync();
        {
            pg8::Gemm g{ACT, WDN, 16384, D, DFF}; pg8::StaticOrder S; S.init(16384, D, G, bx);
            pg8::EpiRes2 E{OUT, PART2, half * 16384};
            pg8::gemm_phase<pg8::EpiRes2, pg8::StaticOrder, PG8_ALIGN, PG8_SP2>(lds, g, S, E);
        }
        grid.sync();
    }

#endif
#ifndef NO_P7
    {
        int tid7 = threadIdx.x; asm volatile("" : "+v"(tid7)); const int lane7 = tid7 & 63, wave7 = __builtin_amdgcn_readfirstlane(tid7 >> 6);
        const int gw = bx * 8 + wave7, NGW = G * 8;
        const f32x4* gf = (const f32x4*)args.in[16] + lane7;
        for (int r = gw; r < MR; r += NGW) {
            const float pv = lane7 < 16 ? PART2[(size_t)r * 16 + lane7] : 0.f;
            const float rs = rsqrtf(wave_sum(pv) * (1.f / D) + EPS);
            f32x4* o = (f32x4*)(OUT + (size_t)r * D) + lane7;
#pragma unroll
            for (int j = 0; j < 4; ++j) { const f32x4 v = o[64 * j], gg = gf[64 * j]; o[64 * j] = v * rs * gg; }
        }
    }
#endif
}

extern "C" void kernel_launch(void* const* d_in, const int* in_sizes, int n_in, void* d_out, int out_size, void* d_ws, size_t ws_size, hipStream_t stream) {
    static int grid = 0;
    if (grid == 0) {
        if (n_in != 17 || out_size != MR * D || ws_size < WS_END) { fprintf(stderr, "kernel_launch: unexpected shapes (n_in %d, out %d, ws %zu < %zu)\n", n_in, out_size, ws_size, (size_t)WS_END); grid = -1; return; }
        int dev = 0, cus = 0, per_cu = 0;
        hipGetDevice(&dev); hipDeviceGetAttribute(&cus, hipDeviceAttributeMultiprocessorCount, dev);
        if (hipFuncSetAttribute((const void*)hymba_fwd, hipFuncAttributeMaxDynamicSharedMemorySize, LDS_BYTES) != hipSuccess) { fprintf(stderr, "kernel_launch: hipFuncSetAttribute failed\n"); grid = -1; return; }
        if (hipOccupancyMaxActiveBlocksPerMultiprocessor(&per_cu, (const void*)hymba_fwd, NTHREADS, LDS_BYTES) != hipSuccess || per_cu < 1) { fprintf(stderr, "kernel_launch: occupancy query says %d\n", per_cu); per_cu = 1; }
        (void)hipGetLastError();
        grid = cus;
    }
    if (grid < 0) return;
    Args a{};
    for (int i = 0; i < 17; ++i) a.in[i] = (const float*)d_in[i];
    a.out = (float*)d_out; a.ws = (unsigned char*)d_ws;
    void* kargs[] = {&a};
    hipError_t e = hipLaunchCooperativeKernel((const void*)hymba_fwd, dim3(grid), dim3(NTHREADS), kargs, LDS_BYTES, stream);
    if (e != hipSuccess) fprintf(stderr, "kernel_launch: cooperative launch failed: %s (grid %d)\n", hipGetErrorString(e), grid);
}
```

```cpp
#include <hip/hip_runtime.h>
#include <hip/hip_cooperative_groups.h>
#include <cstdio>
#include <cstdint>
#include <cmath>
namespace cg = cooperative_groups;
namespace pg8 {
#define PG8_LAS __attribute__((address_space(3)))
typedef unsigned short bf16_t;
typedef short bf16x8 __attribute__((ext_vector_type(8)));
typedef float f32x4 __attribute__((ext_vector_type(4)));
typedef unsigned u32x4 __attribute__((ext_vector_type(4)));
constexpr int BM = 256, BK = 64, HALF = 128, HTB = HALF * BK * 2  , STAGE_BYTES = 8 * HTB, NXCD = 8, WGM = 8;

__host__ __device__ __forceinline__ int lds_byte(int r, int c) { const int st = (r >> 4) * 2 + (c >> 5), rr = r & 15, cc = c & 31, ob = rr * 64 + cc * 2; return st * 1024 + (ob ^ (((ob >> 9) & 1) << 5)); }
__host__ __device__ __forceinline__ void stage_rc(int b, int& R, int& C) { const int st = b / 1024, sb = b % 1024, swz = sb ^ (((sb >> 9) & 1) << 5); R = (st >> 1) * 16 + swz / 64; C = (st & 1) * 32 + (swz % 64) / 2; }
__host__ __device__ __forceinline__ int perm32(int rho) { const int n = rho >> 4, i = rho & 15; return 8 * (i >> 2) + 4 * n + (i & 3); }

struct Unit { int pm, pn; };
struct Gemm { const bf16_t* A; const bf16_t* Bt; int M, N, K; };

struct StaticOrder {
    int nM, nN, nwg, G, c;
    __host__ __device__ void init(int M, int N, int G_, int c_) { nM = M / BM; nN = N / BM; nwg = nM * nN; G = G_; c = c_; }
    __host__ __device__ bool next(int i, Unit& u) const {
        const long L = (long)i * G + c; if (L >= nwg) return false;
        int wgid = (int)L; { const int q = nwg / NXCD, r = nwg % NXCD, xcd = wgid % NXCD, off = wgid / NXCD; wgid = (xcd < r ? xcd * (q + 1) : r * (q + 1) + (xcd - r) * q) + off; }
        const int nig = WGM * nN, gid = wgid / nig, fm = gid * WGM, gsz = (nM - fm) < WGM ? (nM - fm) : WGM;
        u.pm = fm + ((wgid % nig) % gsz); u.pn = (wgid % nig) / gsz; return true;
    }
    __device__ __forceinline__ void a_ready(const Unit&) const {}
    __device__ __forceinline__ void done(const Unit&) const {}
};

__device__ __forceinline__ unsigned cvt_pk_bf16(float lo, float hi) { unsigned r; asm volatile("v_cvt_pk_bf16_f32 %0, %1, %2" : "=v"(r) : "v"(lo), "v"(hi)); return r; }
__device__ __forceinline__ u32x4 pack8(const f32x4 v0, const f32x4 v1) { u32x4 w; w.x = cvt_pk_bf16(v0[0], v0[1]); w.y = cvt_pk_bf16(v0[2], v0[3]); w.z = cvt_pk_bf16(v1[0], v1[1]); w.w = cvt_pk_bf16(v1[2], v1[3]); return w; }
struct EpiInProj {
    static constexpr bool PERM = true, AFTER_DRAIN = false;
    bf16_t* QK; size_t qk_stride; bf16_t* Vt; int ldv; float qscale;
    __device__ __forceinline__ void operator()(const f32x4 (&acc)[2][2][4][2], const Unit& u, int wr, int wc, int fr, int fq) const {
        bf16_t* base; int ldc, row0, col0; float sc = 1.f;
        if (u.pm < 129) { int colt = (u.pn - 129) * BM; const int t = colt >> 9; colt &= 511; base = QK + (size_t)t * qk_stride; ldc = 512; row0 = u.pm * BM; col0 = colt; if ((t & 1) == 0) sc = qscale; }
        else { base = Vt; ldc = ldv; row0 = (u.pm - 137) * BM; col0 = u.pn * BM; }
        row0 += wr * 64 + fr; col0 += wc * 32 + 8 * fq;
#pragma unroll
        for (int ai = 0; ai < 2; ++ai)
#pragma unroll
            for (int m = 0; m < 4; ++m) { bf16_t* rowp = base + (size_t)(row0 + ai * HALF + m * 16) * ldc + col0;
#pragma unroll
                for (int bj = 0; bj < 2; ++bj) *(u32x4*)(rowp + bj * HALF) = pack8(acc[ai][bj][m][0] * sc, acc[ai][bj][m][1] * sc); }
    }
};
struct EpiPlain {
    static constexpr bool PERM = true, AFTER_DRAIN = false;
    bf16_t* O; int ldc;
    __device__ __forceinline__ void operator()(const f32x4 (&acc)[2][2][4][2], const Unit& u, int wr, int wc, int fr, int fq) const {
        const int row0 = u.pm * BM + wr * 64 + fr, col0 = u.pn * BM + wc * 32 + 8 * fq;
#pragma unroll
        for (int ai = 0; ai < 2; ++ai)
#pragma unroll
            for (int m = 0; m < 4; ++m) { bf16_t* rowp = O + (size_t)(row0 + ai * HALF + m * 16) * ldc + col0;
#pragma unroll
                for (int bj = 0; bj < 2; ++bj) *(u32x4*)(rowp + bj * HALF) = pack8(acc[ai][bj][m][0], acc[ai][bj][m][1]); }
    }
};
struct EpiRes1 {
    static constexpr bool PERM = true, AFTER_DRAIN = false;
    const float* x; const float* meta; float* h1; bf16_t* h1b; float* part;
    __device__ __forceinline__ void operator()(const f32x4 (&acc)[2][2][4][2], const Unit& u, int wr, int wc, int fr, int fq) const {
        const int row0 = u.pm * BM + wr * 64 + fr, col0 = u.pn * BM + wc * 32 + 8 * fq;
#pragma unroll
        for (int ai = 0; ai < 2; ++ai)
#pragma unroll
            for (int m = 0; m < 4; ++m) {
                const int r = row0 + ai * HALF + m * 16; const bool real = r < 32768, hasres = r < 32784;
                const float* res = real ? x + (size_t)r * 1024 : meta + (size_t)(hasres ? r - 32768 : 0) * 1024;
                float ss = 0.f;
#pragma unroll
                for (int bj = 0; bj < 2; ++bj) { const int c = col0 + bj * HALF;
                    f32x4 v0 = acc[ai][bj][m][0], v1 = acc[ai][bj][m][1];
                    if (hasres) { v0 = v0 + *(const f32x4*)(res + c); v1 = v1 + *(const f32x4*)(res + c + 4); }
                    ss += (v0[0] * v0[0] + v0[1] * v0[1]) + (v0[2] * v0[2] + v0[3] * v0[3]) + (v1[0] * v1[0] + v1[1] * v1[1]) + (v1[2] * v1[2] + v1[3] * v1[3]);
                    if (real) { *(f32x4*)(h1 + (size_t)r * 1024 + c) = v0; *(f32x4*)(h1 + (size_t)r * 1024 + c + 4) = v1; }
                    *(u32x4*)(h1b + (size_t)r * 1024 + c) = pack8(v0, v1); }
                ss += __shfl_xor(ss, 16); ss += __shfl_xor(ss, 32);
                if (fq == 0) part[(size_t)r * 16 + u.pn * 4 + wc] = ss;
            }
    }
};
struct EpiRes2 {
    static constexpr bool PERM = true, AFTER_DRAIN = false;
    float* h; float* part; int rowoff;
    __device__ __forceinline__ void operator()(const f32x4 (&acc)[2][2][4][2], const Unit& u, int wr, int wc, int fr, int fq) const {
        const int row0 = rowoff + u.pm * BM + wr * 64 + fr, col0 = u.pn * BM + wc * 32 + 8 * fq;
#pragma unroll
        for (int ai = 0; ai < 2; ++ai)
#pragma unroll
            for (int m = 0; m < 4; ++m) {
                const int r = row0 + ai * HALF + m * 16; float* hr = h + (size_t)r * 1024;
                float ss = 0.f;
#pragma unroll
                for (int bj = 0; bj < 2; ++bj) { const int c = col0 + bj * HALF;
                    const f32x4 v0 = acc[ai][bj][m][0] + *(const f32x4*)(hr + c), v1 = acc[ai][bj][m][1] + *(const f32x4*)(hr + c + 4);
                    ss += (v0[0] * v0[0] + v0[1] * v0[1]) + (v0[2] * v0[2] + v0[3] * v0[3]) + (v1[0] * v1[0] + v1[1] * v1[1]) + (v1[2] * v1[2] + v1[3] * v1[3]);
                    *(f32x4*)(hr + c) = v0; *(f32x4*)(hr + c + 4) = v1; }
                ss += __shfl_xor(ss, 16); ss += __shfl_xor(ss, 32);
                if (fq == 0) part[(size_t)r * 16 + u.pn * 4 + wc] = ss;
            }
    }
};
struct OrderInProj {
    int G, c;
    __device__ __forceinline__ bool next(int i, Unit& u) const {
        const int L = i * G + c; if (L >= 1548) return false;
        if (L < 1024) { const int x = L & 7, j = (L >> 3) & 31, rnd = L >> 8; u.pm = 32 * rnd + 4 * x + (j >> 3); u.pn = 129 + (j & 7); return true; }
        int V = L - 1024;
        if (V < 516) { if (V < 512) { const int x = V & 7, j = (V >> 3) & 31, r2 = V >> 8; V = r2 * 256 + x * 32 + j; } u.pm = 137 + (V & 3); u.pn = V >> 2; return true; }
        u.pm = 128; u.pn = 129 + (V - 516); return true;
    }
    __device__ __forceinline__ void a_ready(const Unit&) const {}
    __device__ __forceinline__ void done(const Unit&) const {}
};

template <class Epi, class Sched, bool ALIGN_EPI = false, bool SP2 = false>
__device__ __forceinline__ void gemm_phase(PG8_LAS unsigned char* lds, const Gemm g, const Sched& S, const Epi& E) {
    int tid_ = threadIdx.x; asm volatile("" : "+v"(tid_));
    const int tid = tid_, wid = __builtin_amdgcn_readfirstlane(tid >> 6), lane = tid & 63, wr = wid >> 2, wc = wid & 3, fr = lane & 15, fq = lane >> 4;
    const int K = g.K, nt = K / BK;
    unsigned voffA[2], voffB[2];
#pragma unroll
    for (int i = 0; i < 2; ++i) { int R, C; stage_rc(tid * 16 + i * 8192, R, C); const int Rb = Epi::PERM ? ((R & ~31) + perm32(R & 31)) : R;
        voffA[i] = (unsigned)(R * K + C) * 2u; voffB[i] = (unsigned)(Rb * K + C) * 2u; }
    const size_t kstep = (size_t)(BK * 2);
    const size_t hstep = (size_t)HALF * K * 2;
    const size_t tstep = 2 * hstep;
    const unsigned ldsw = (unsigned)wid * 1024u;
    const int aoff = lds_byte(wr * 64 + fr, fq * 8), boff = lds_byte(wc * 32 + fr, fq * 8);
#define PG8_SA(b, h) (((b) * 2 + (h)) * HTB)
#define PG8_SB(b, h) ((4 + (b) * 2 + (h)) * HTB)
#define PG8_STAGE(bufoff, gbase, voff) do { _Pragma("unroll") for (int _i = 0; _i < 2; ++_i) \
        __builtin_amdgcn_global_load_lds((const unsigned*)((const char*)(gbase) + (voff)[_i]), (PG8_LAS unsigned*)(lds + (bufoff) + ldsw + _i * 8192), 16, 0, 0); } while (0)
#define PG8_LDA(dst, b, h) do { _Pragma("unroll") for (int m = 0; m < 4; ++m) _Pragma("unroll") for (int k = 0; k < 2; ++k) dst[m][k] = *(const PG8_LAS bf16x8*)(lds + PG8_SA(b, h) + aoff + m * 2048 + k * 1024); } while (0)
#define PG8_LDB(dst, b, h) do { _Pragma("unroll") for (int n = 0; n < 2; ++n) _Pragma("unroll") for (int k = 0; k < 2; ++k) dst[n][k] = *(const PG8_LAS bf16x8*)(lds + PG8_SB(b, h) + boff + n * 2048 + k * 1024); } while (0)
#define PG8_MMA(ai, bj, At, Bt) do { __builtin_amdgcn_s_setprio(1); _Pragma("unroll") for (int m = 0; m < 4; ++m) _Pragma("unroll") for (int n = 0; n < 2; ++n) _Pragma("unroll") for (int k = 0; k < 2; ++k) \
        acc[ai][bj][m][n] = __builtin_amdgcn_mfma_f32_16x16x32_bf16(Bt[n][k], At[m][k], acc[ai][bj][m][n], 0, 0, 0); __builtin_amdgcn_s_setprio(0); } while (0)
#define PG8_WAIT_V(n) asm volatile("s_waitcnt vmcnt(" #n ")" ::: "memory")
#define PG8_WAIT_L(n) asm volatile("s_waitcnt lgkmcnt(" #n ")" ::: "memory")
#define PG8_BAR __builtin_amdgcn_s_barrier()
#define PG8_SCHED __builtin_amdgcn_sched_barrier(0)
    Unit cur, nxt; int ui = 0;
    if (!S.next(0, cur)) return;
    f32x4 acc[2][2][4][2];
#pragma unroll
    for (int a = 0; a < 2; ++a)
#pragma unroll
        for (int b = 0; b < 2; ++b)
#pragma unroll
            for (int m = 0; m < 4; ++m)
#pragma unroll
                for (int n = 0; n < 2; ++n) acc[a][b][m][n] = (f32x4){0.f, 0.f, 0.f, 0.f};
    bf16x8 At[4][2], B0[2][2], B1[2][2];
    const char* cA = (const char*)g.A + (size_t)cur.pm * tstep; const char* cB = (const char*)g.Bt + (size_t)cur.pn * tstep;
    S.a_ready(cur);
    if constexpr (SP2) {
        PG8_STAGE(PG8_SB(0, 0), cB, voffB); PG8_STAGE(PG8_SB(0, 1), cB + hstep, voffB); PG8_STAGE(PG8_SA(0, 0), cA, voffA); PG8_STAGE(PG8_SA(0, 1), cA + hstep, voffA);
        if (wr == 1) PG8_BAR;
        PG8_WAIT_V(2); PG8_BAR;
        PG8_STAGE(PG8_SB(1, 0), cB + kstep, voffB); PG8_STAGE(PG8_SA(1, 0), cA + kstep, voffA); PG8_STAGE(PG8_SB(1, 1), cB + hstep + kstep, voffB);
        PG8_WAIT_V(6); PG8_BAR;
    } else {
        PG8_STAGE(PG8_SB(0, 0), cB, voffB); PG8_STAGE(PG8_SA(0, 0), cA, voffA); PG8_STAGE(PG8_SB(0, 1), cB + hstep, voffB); PG8_STAGE(PG8_SA(0, 1), cA + hstep, voffA);
        if (wr == 1) PG8_BAR;
        PG8_WAIT_V(4); PG8_BAR;
        PG8_STAGE(PG8_SB(1, 0), cB + kstep, voffB); PG8_STAGE(PG8_SA(1, 0), cA + kstep, voffA); PG8_STAGE(PG8_SB(1, 1), cB + hstep + kstep, voffB);
        PG8_WAIT_V(6); PG8_BAR;
    }
    for (;;) {
        const bool has_next = S.next(ui + 1, nxt);
        const char* nA = has_next ? (const char*)g.A + (size_t)nxt.pm * tstep : cA; const char* nB = has_next ? (const char*)g.Bt + (size_t)nxt.pn * tstep : cB;
        for (int t = 0; t < nt; t += 2) {
            const bool last = (t == nt - 2);
            const char* a1 = cA + (size_t)(t + 1) * kstep;
            const char* a2 = last ? nA : cA + (size_t)(t + 2) * kstep; const char* b2 = last ? nB : cB + (size_t)(t + 2) * kstep;
            const char* a3 = a2 + kstep; const char* b3 = b2 + kstep;
            if (last && has_next) S.a_ready(nxt);
            if constexpr (SP2) {
            PG8_LDB(B0, 0, 0); PG8_LDB(B1, 0, 1); PG8_SCHED; PG8_LDA(At, 0, 0); PG8_STAGE(PG8_SA(1, 1), a1 + hstep, voffA);
            PG8_WAIT_V(8); PG8_WAIT_L(0); PG8_BAR; PG8_MMA(0, 0, At, B0); PG8_MMA(0, 1, At, B1); PG8_BAR; PG8_SCHED;
            PG8_LDA(At, 0, 1); PG8_STAGE(PG8_SB(0, 0), b2, voffB); PG8_STAGE(PG8_SB(0, 1), b2 + hstep, voffB); PG8_STAGE(PG8_SA(0, 0), a2, voffA);
            PG8_WAIT_V(8); PG8_WAIT_L(0); PG8_BAR; PG8_MMA(1, 0, At, B0); PG8_MMA(1, 1, At, B1); PG8_BAR; PG8_SCHED;
            PG8_LDB(B0, 1, 0); PG8_LDB(B1, 1, 1); PG8_SCHED; PG8_LDA(At, 1, 0); PG8_STAGE(PG8_SA(0, 1), a2 + hstep, voffA);
            PG8_WAIT_V(8); PG8_WAIT_L(0); PG8_BAR; PG8_MMA(0, 0, At, B0); PG8_MMA(0, 1, At, B1); PG8_BAR; PG8_SCHED;
            PG8_LDA(At, 1, 1); PG8_STAGE(PG8_SB(1, 0), b3, voffB); PG8_STAGE(PG8_SB(1, 1), b3 + hstep, voffB); PG8_STAGE(PG8_SA(1, 0), a3, voffA);
            PG8_WAIT_V(8); PG8_WAIT_L(0); PG8_BAR; PG8_MMA(1, 0, At, B0); PG8_MMA(1, 1, At, B1); PG8_BAR; PG8_SCHED;
            } else {
            PG8_LDB(B0, 0, 0); PG8_SCHED; PG8_LDA(At, 0, 0); PG8_STAGE(PG8_SA(1, 1), a1 + hstep, voffA);
            PG8_WAIT_L(8); PG8_BAR; PG8_WAIT_L(0); PG8_MMA(0, 0, At, B0); PG8_BAR; PG8_SCHED;
            PG8_LDB(B1, 0, 1); PG8_STAGE(PG8_SB(0, 0), b2, voffB);
            PG8_BAR; PG8_WAIT_L(0); PG8_MMA(0, 1, At, B1); PG8_BAR;
            PG8_LDA(At, 0, 1); PG8_STAGE(PG8_SA(0, 0), a2, voffA);
            PG8_BAR; PG8_WAIT_L(0); PG8_MMA(1, 0, At, B0); PG8_BAR; PG8_SCHED;
            PG8_STAGE(PG8_SB(0, 1), b2 + hstep, voffB);
            PG8_WAIT_V(6); PG8_BAR; PG8_MMA(1, 1, At, B1); PG8_BAR;
            PG8_LDB(B0, 1, 0); PG8_SCHED; PG8_LDA(At, 1, 0); PG8_STAGE(PG8_SA(0, 1), a2 + hstep, voffA);
            PG8_WAIT_L(8); PG8_BAR; PG8_WAIT_L(0); PG8_MMA(0, 0, At, B0); PG8_BAR; PG8_SCHED;
            PG8_LDB(B1, 1, 1); PG8_STAGE(PG8_SB(1, 0), b3, voffB);
            PG8_BAR; PG8_WAIT_L(0); PG8_MMA(0, 1, At, B1); PG8_BAR;
            PG8_LDA(At, 1, 1); PG8_STAGE(PG8_SA(1, 0), a3, voffA);
            PG8_BAR; PG8_WAIT_L(0); PG8_MMA(1, 0, At, B0); PG8_BAR; PG8_SCHED;
            PG8_STAGE(PG8_SB(1, 1), b3 + hstep, voffB);
            PG8_WAIT_V(6); PG8_BAR; PG8_MMA(1, 1, At, B1); PG8_BAR;
            }
        }
        if constexpr (ALIGN_EPI) { if (wr == 0) PG8_BAR; }
        if constexpr (!Epi::AFTER_DRAIN) { E(acc, cur, wr, wc, fr, fq); S.done(cur); }
        if (!has_next) break;
#pragma unroll
        for (int a = 0; a < 2; ++a)
#pragma unroll
            for (int b = 0; b < 2; ++b)
#pragma unroll
                for (int m = 0; m < 4; ++m)
#pragma unroll
                    for (int n = 0; n < 2; ++n) acc[a][b][m][n] = (f32x4){0.f, 0.f, 0.f, 0.f};
        cur = nxt; cA = nA; cB = nB; ++ui;
        if constexpr (ALIGN_EPI) { if (wr == 1) PG8_BAR; }
    }
    PG8_WAIT_V(0);
    if constexpr (!ALIGN_EPI) { if (wr == 0) PG8_BAR; }
    PG8_BAR;
    if constexpr (Epi::AFTER_DRAIN) { E.fused(acc, cur, wr, wc, fr, fq, lds, wid, lane); S.done(cur); }
#undef PG8_SA
#undef PG8_SB
#undef PG8_STAGE
#undef PG8_LDA
#undef PG8_LDB
#undef PG8_MMA
#undef PG8_WAIT_V
#undef PG8_WAIT_L
#undef PG8_BAR
#undef PG8_SCHED
}
}
#ifndef PG8_SP2
#define PG8_SP2 true
#endif
#ifndef PG8_ALIGN
#define PG8_ALIGN true
#endif

#define LAS __attribute__((address_space(3)))
typedef unsigned short bf16_t;
typedef short bf16x8 __attribute__((ext_vector_type(8)));
typedef float f32x4 __attribute__((ext_vector_type(4)));
typedef float f32x16 __attribute__((ext_vector_type(16)));
typedef unsigned u32x4 __attribute__((ext_vector_type(4)));
typedef unsigned u32x2 __attribute__((ext_vector_type(2)));
constexpr int NB = 16, T = 2048, D = 1024, MR = NB * T, MP = 33024, META0 = 32768;
constexpr int DFF = 2816, NUP = 5632;
constexpr float EPS = 1e-6f, LOG2E = 1.4426950408889634f;
constexpr size_t MiB = 1u << 20;
constexpr size_t WS_XB = 0;
constexpr size_t WS_WIN = (size_t)MP * D * 2;
constexpr size_t WS_WOUT = 71 * MiB;
constexpr size_t WS_WUP = 73 * MiB;
constexpr size_t WS_ACT = 0;
constexpr size_t WS_CTL = 88 * MiB, CTL_BYTES = 16384;
constexpr size_t WS_WDN = 90 * MiB;
constexpr size_t WS_PART1 = 96 * MiB, WS_PART2 = 99 * MiB, WS_RSTD1 = 101 * MiB;
constexpr size_t WS_R = 102 * MiB;
constexpr size_t QK_STRIDE = (size_t)MP * 512;
constexpr size_t WS_QK = WS_R, WS_VT = WS_R + 4 * QK_STRIDE * 2, WS_MRG = WS_VT + (size_t)1024 * MP * 2;
constexpr size_t WS_END = WS_R + (size_t)MP * NUP * 2;
static_assert(WS_WIN + (size_t)3072 * D * 2 <= WS_WOUT && WS_MRG + (size_t)MP * D * 2 <= WS_END && (size_t)16384 * DFF * 2 <= WS_WDN, "ws map");
constexpr int LDS_BYTES = 147456;
constexpr int NTHREADS = 512;
constexpr int LDS_MISC = 131072 + 1024;

__device__ __forceinline__ unsigned cvtpk(float lo, float hi) { typedef float f2 __attribute__((ext_vector_type(2))); typedef __bf16 b2 __attribute__((ext_vector_type(2))); f2 v = {lo, hi}; b2 b = __builtin_convertvector(v, b2); return __builtin_bit_cast(unsigned, b); }
__device__ __forceinline__ float wave_sum(float v) {
#pragma unroll
    for (int o = 1; o < 64; o <<= 1) v += __shfl_xor(v, o);
    return v;
}
#define LDS_WAIT() asm volatile("s_waitcnt lgkmcnt(0)" ::: "memory")

template <int MODE> __device__ __forceinline__ void transpose_item(const float* W, int K, int N, bf16_t* WT, LAS float* scr, int item, int lane, const float* g0, const float* g1) {
    const int nblk = N / 32, kb = item / nblk, nb = item % nblk, k0 = 64 * kb, n0 = 32 * nb;
#pragma unroll 8
    for (int i = 0; i < 32; ++i) { const int kk = 2 * i + (lane >> 5), k = k0 + kk; float s = 1.f;
        if (MODE == 1 || MODE == 3) s = g0[k];
        if (MODE == 2) s = k < 512 ? g0[k & 127] * 0.8f : g1[(k - 512) & 63];
        scr[kk * 33 + (lane & 31)] = W[(size_t)k * N + n0 + (lane & 31)] * s; }
    LDS_WAIT(); asm volatile("" ::: "memory");
    int d0 = n0;
    if (MODE == 1) { const int seg = n0 >> 9; const int ns = seg == 2 ? 4 : (seg == 3 ? 2 : (seg == 4 ? 3 : seg)); d0 = ns * 512 + (n0 & 511); }
    const int c = lane & 7;
#pragma unroll
    for (int j = 0; j < 4; ++j) { const int n = (lane >> 3) + 8 * j; const LAS float* s = scr + (8 * c) * 33 + n;
        u32x4 o; o.x = cvtpk(s[0 * 33], s[1 * 33]); o.y = cvtpk(s[2 * 33], s[3 * 33]); o.z = cvtpk(s[4 * 33], s[5 * 33]); o.w = cvtpk(s[6 * 33], s[7 * 33]);
        *(u32x4*)(WT + (size_t)(d0 + n) * K + k0 + 8 * c) = o; }
    LDS_WAIT(); asm volatile("" ::: "memory");
}
__device__ __forceinline__ void rms_row_to_bf16(const float* xrow, bf16_t* orow, int lane) {
    const f32x4* xr = (const f32x4*)xrow + lane;
    f32x4 v[4]; float s = 0.f;
#pragma unroll
    for (int j = 0; j < 4; ++j) { v[j] = xr[64 * j]; s += (v[j].x * v[j].x + v[j].y * v[j].y) + (v[j].z * v[j].z + v[j].w * v[j].w); }
    const float rs = rsqrtf(wave_sum(s) * (1.f / D) + EPS);
    u32x2* o8 = (u32x2*)orow + lane;
#pragma unroll
    for (int j = 0; j < 4; ++j) { u32x2 w; w.x = cvtpk(v[j].x * rs, v[j].y * rs); w.y = cvtpk(v[j].z * rs, v[j].w * rs); o8[64 * j] = w; }
}

constexpr int KROW = 144;
constexpr int DF_K1 = 0, DF_K2 = 64 * KROW, DF_V = 2 * 64 * KROW, DF_BUF = DF_V + 128 * KROW;
constexpr int SB_K = 0, SB_V = 64 * KROW, SB_BUF = 2 * 64 * KROW;
__device__ __forceinline__ int pi32(int r) { return (r & 0x13) | ((r & 4) << 1) | ((r & 8) >> 1); }
__device__ __forceinline__ bf16x8 pack_frag(float a0, float a1, float a2, float a3, float a4, float a5, float a6, float a7) {
    u32x4 w; w.x = cvtpk(a0, a1); w.y = cvtpk(a2, a3); w.z = cvtpk(a4, a5); w.w = cvtpk(a6, a7); return __builtin_bit_cast(bf16x8, w); }
#define MFMA32(a, b, c) __builtin_amdgcn_mfma_f32_32x32x16_bf16(a, b, c, 0, 0, 0)

__device__ __forceinline__ void diff_unit(LAS unsigned char* lds, const bf16_t* Qd, const bf16_t* Kd, const bf16_t* Vt, bf16_t* merged,
                                          int h, int krow_real, int qrow0, int qpos0, int kt_hi, int nvalid, float cs, float lam, int tid) {
    const int lane = tid & 63, wid = __builtin_amdgcn_readfirstlane(tid >> 6), map = wid >> 2, wq = wid & 3, ql = lane & 31, hl = lane >> 5;
    const int skey = tid >> 3, sch = tid & 7;
    const bf16_t* gK = Kd + (size_t)skey * 512 + h * 128 + sch * 8;
    const bf16_t* gV = Vt + (size_t)(h * 128 + skey) * MP + sch * 8;
    const int sK = skey * KROW + sch * 16;
    u32x4 rk1, rk2, rv0, rv1;
#define DF_LOAD(kt_) do { const int krow_ = (kt_) == 0 ? META0 - 48 : krow_real + 64 * ((kt_) - 1); rk1 = *(const u32x4*)(gK + (size_t)krow_ * 512); rk2 = *(const u32x4*)(gK + (size_t)krow_ * 512 + 64); \
        rv0 = *(const u32x4*)(gV + krow_); rv1 = *(const u32x4*)(gV + krow_ + (size_t)64 * MP); } while (0)
#define DF_STORE(b_) do { LAS unsigned char* d_ = lds + (b_) * DF_BUF + sK; *(LAS u32x4*)(d_ + DF_K1) = rk1; *(LAS u32x4*)(d_ + DF_K2) = rk2; *(LAS u32x4*)(d_ + DF_V) = rv0; *(LAS u32x4*)(d_ + DF_V + 64 * KROW) = rv1; } while (0)
    const int qrow = qrow0 + 32 * wq + ql, qpos = qpos0 + 32 * wq + ql, qw = qpos0 + 32 * wq;
    bf16x8 qf[4];
#pragma unroll
    for (int ks = 0; ks < 4; ++ks) qf[ks] = *(const bf16x8*)(Qd + (size_t)qrow * 512 + h * 128 + map * 64 + 16 * ks + 8 * hl);
    f32x16 o[4];
#pragma unroll
    for (int et = 0; et < 4; ++et)
#pragma unroll
        for (int r = 0; r < 16; ++r) o[et][r] = 0.f;
    float m = -INFINITY, l = 0.f;
    const int kaddr = (map ? DF_K2 : DF_K1) + pi32(ql) * KROW + 16 * hl;
    const int vaddr = DF_V + ql * KROW + 16 * hl;
    DF_LOAD(kt_hi); DF_STORE(0); __syncthreads();
    int buf = 0;
    for (int kt = kt_hi; kt >= 0; --kt) {
        if (kt > 0) DF_LOAD(kt - 1);
        const bool skip = (kt > 0) && (64 * kt - 48 > qw + 31);
        if (!skip) {
            const bool full = (kt > 0) && (64 * kt + 15 <= qw);
            const LAS unsigned char* Lb = lds + buf * DF_BUF;
            f32x16 sc[2];
            const float kb = cs * (float)(64 * kt - 48 + 8 * hl);
#pragma unroll
            for (int c = 0; c < 2; ++c)
#pragma unroll
                for (int r = 0; r < 16; ++r) sc[c][r] = __builtin_fmaf(cs, (float)(32 * c + 16 * (r >> 3) + (r & 7)), kb);
#pragma unroll
            for (int c = 0; c < 2; ++c)
#pragma unroll
                for (int ks = 0; ks < 4; ++ks) { const bf16x8 kf = *(const LAS bf16x8*)(Lb + kaddr + c * 32 * KROW + ks * 32); sc[c] = MFMA32(kf, qf[ks], sc[c]); }
            if (!full) {
                const int kp0 = 64 * kt - 48 + 8 * hl;
#pragma unroll
                for (int c = 0; c < 2; ++c)
#pragma unroll
                    for (int r = 0; r < 16; ++r) { const int kpos = kp0 + 32 * c + 16 * (r >> 3) + (r & 7); if (!(kpos >= 0 && kpos <= qpos)) sc[c][r] = -INFINITY; }
            }
            float mx = sc[0][0];
#pragma unroll
            for (int r = 1; r < 16; ++r) mx = fmaxf(mx, sc[0][r]);
#pragma unroll
            for (int r = 0; r < 16; ++r) mx = fmaxf(mx, sc[1][r]);
            mx = fmaxf(mx, __shfl_xor(mx, 32));
            if (__any(mx > m + 8.f)) {
                const float mn = fmaxf(m, mx); const float al = (m == -INFINITY) ? 0.f : __builtin_amdgcn_exp2f(m - mn);
                l *= al;
#pragma unroll
                for (int et = 0; et < 4; ++et)
#pragma unroll
                    for (int r = 0; r < 16; ++r) o[et][r] *= al;
                m = mn;
            }
            const float mref = (m == -INFINITY) ? 0.f : m;
            float ls = 0.f;
#pragma unroll
            for (int c = 0; c < 2; ++c)
#pragma unroll
                for (int r = 0; r < 16; ++r) { sc[c][r] = __builtin_amdgcn_exp2f(sc[c][r] - mref); ls += sc[c][r]; }
            l += ls;
            bf16x8 pf[2][2];
#pragma unroll
            for (int c = 0; c < 2; ++c)
#pragma unroll
                for (int s = 0; s < 2; ++s) pf[c][s] = pack_frag(sc[c][8 * s], sc[c][8 * s + 1], sc[c][8 * s + 2], sc[c][8 * s + 3], sc[c][8 * s + 4], sc[c][8 * s + 5], sc[c][8 * s + 6], sc[c][8 * s + 7]);
#pragma unroll
            for (int et = 0; et < 4; ++et)
#pragma unroll
                for (int c = 0; c < 2; ++c)
#pragma unroll
                    for (int s = 0; s < 2; ++s) { const bf16x8 vf = *(const LAS bf16x8*)(Lb + vaddr + et * 32 * KROW + c * 64 + s * 32); o[et] = MFMA32(vf, pf[c][s], o[et]); }
        }
        if (kt > 0) DF_STORE(buf ^ 1);
        __syncthreads();
        buf ^= 1;
    }
#undef DF_LOAD
#undef DF_STORE
    l += __shfl_xor(l, 32);
    const float inv = 1.f / l;
    LAS float* xch = (LAS float*)lds + wq * 4096 + lane;
    if (map == 1) { const float f = lam * inv;
#pragma unroll
        for (int et = 0; et < 4; ++et)
#pragma unroll
            for (int r = 0; r < 16; ++r) xch[(et * 16 + r) * 64] = o[et][r] * f; }
    __syncthreads();
    if (map == 0) {
        float ss = 0.f;
#pragma unroll
        for (int et = 0; et < 4; ++et)
#pragma unroll
            for (int r = 0; r < 16; ++r) { const float v = o[et][r] * inv - xch[(et * 16 + r) * 64]; o[et][r] = v; ss += v * v; }
        ss += __shfl_xor(ss, 32);
        const float rs = rsqrtf(ss * (1.f / 128.f) + EPS);
        if (32 * wq + ql < nvalid) {
            bf16_t* op = merged + (size_t)qrow * 1024 + h * 128 + 4 * hl;
#pragma unroll
            for (int et = 0; et < 4; ++et)
#pragma unroll
                for (int g = 0; g < 4; ++g) { u32x2 w; w.x = cvtpk(o[et][4 * g] * rs, o[et][4 * g + 1] * rs); w.y = cvtpk(o[et][4 * g + 2] * rs, o[et][4 * g + 3] * rs); *(u32x2*)(op + 32 * et + 8 * g) = w; }
        }
    }
    __syncthreads();
}

__device__ __forceinline__ void sb_unit(LAS unsigned char* lds, const bf16_t* Qs, const bf16_t* Ks, const bf16_t* Vt, bf16_t* merged,
                                        int h, int krow_real, int qrow0, int qpos0, int kt_hi, int nvalid, int tid) {
    const int lane = tid & 63, wid = __builtin_amdgcn_readfirstlane(tid >> 6), ql = lane & 31, hl = lane >> 5;
    const int skey = tid >> 3, sch = tid & 7;
    const bf16_t* gK = Ks + (size_t)skey * 512 + h * 64 + sch * 8;
    const bf16_t* gV = Vt + (size_t)(512 + h * 64 + skey) * MP + sch * 8;
    const int sK = skey * KROW + sch * 16;
    u32x4 rk, rv;
#define SB_LOAD(kt_) do { const int krow_ = (kt_) == 0 ? META0 - 48 : krow_real + 64 * ((kt_) - 1); rk = *(const u32x4*)(gK + (size_t)krow_ * 512); rv = *(const u32x4*)(gV + krow_); } while (0)
#define SB_STORE(b_) do { LAS unsigned char* d_ = lds + (b_) * SB_BUF + sK; *(LAS u32x4*)(d_ + SB_K) = rk; *(LAS u32x4*)(d_ + SB_V) = rv; } while (0)
    const int qrow = qrow0 + 32 * wid + ql, qpos = qpos0 + 32 * wid + ql, qw = qpos0 + 32 * wid;
    bf16x8 qf[4];
#pragma unroll
    for (int ks = 0; ks < 4; ++ks) qf[ks] = *(const bf16x8*)(Qs + (size_t)qrow * 512 + h * 64 + 16 * ks + 8 * hl);
    f32x16 o[2];
#pragma unroll
    for (int et = 0; et < 2; ++et)
#pragma unroll
        for (int r = 0; r < 16; ++r) o[et][r] = 0.f;
    float R = 1.f;
    LAS unsigned* flg = (LAS unsigned*)(lds + LDS_MISC + 64);
    const int kaddr = SB_K + pi32(ql) * KROW + 16 * hl;
    const int vaddr = SB_V + ql * KROW + 16 * hl;
    SB_LOAD(kt_hi); SB_STORE(0); __syncthreads();
    int buf = 0;
    for (int kt = kt_hi; kt >= 0; --kt) {
        if (kt > 0) SB_LOAD(kt - 1);
        const bool skip = (kt > 0) && (64 * kt - 48 >= qw + 31);
        if (!skip) {
            const bool full = (kt > 0) && (64 * kt + 15 < qw);
            const LAS unsigned char* Lb = lds + buf * SB_BUF;
            f32x16 sc[2];
#pragma unroll
            for (int c = 0; c < 2; ++c) {
#pragma unroll
                for (int r = 0; r < 16; ++r) sc[c][r] = 0.f;
#pragma unroll
                for (int ks = 0; ks < 4; ++ks) { const bf16x8 kf = *(const LAS bf16x8*)(Lb + kaddr + c * 32 * KROW + ks * 32); sc[c] = MFMA32(kf, qf[ks], sc[c]); }
            }
            bf16x8 pf[2][2];
            const int kp0 = 64 * kt - 48 + 8 * hl;
#pragma unroll
            for (int c = 1; c >= 0; --c)
#pragma unroll
                for (int s = 1; s >= 0; --s) {
                    float sg[8], ci[8];
#pragma unroll
                    for (int j = 0; j < 8; ++j) { float u = __builtin_amdgcn_exp2f(fminf(sc[c][8 * s + j], 100.f));
                        if (!full) { const int kpos = kp0 + 32 * c + 16 * s + j; if (!(kpos >= 0 && kpos < qpos)) u = 0.f; }
                        ci[j] = __builtin_amdgcn_rcpf(1.f + u); sg[j] = u * ci[j]; }
                    float e = 1.f;
#pragma unroll
                    for (int j = 7; j >= 0; --j) { sg[j] *= e; e *= ci[j]; }
                    const float ep = __shfl_xor(e, 32);
                    const float F = R * (hl ? 1.f : ep);
                    R *= e * ep;
                    pf[c][s] = pack_frag(sg[0] * F, sg[1] * F, sg[2] * F, sg[3] * F, sg[4] * F, sg[5] * F, sg[6] * F, sg[7] * F);
                }
#pragma unroll
            for (int et = 0; et < 2; ++et)
#pragma unroll
                for (int c = 0; c < 2; ++c)
#pragma unroll
                    for (int s = 0; s < 2; ++s) { const bf16x8 vf = *(const LAS bf16x8*)(Lb + vaddr + et * 32 * KROW + c * 64 + s * 32); o[et] = MFMA32(vf, pf[c][s], o[et]); }
        }
        if (kt > 0) SB_STORE(buf ^ 1);
        if (lane == 0) flg[(kt & 1) * 8 + wid] = __all(R < 1e-30f) ? 1u : 0u;
        __syncthreads();
        buf ^= 1;
        { const LAS u32x4* f4 = (const LAS u32x4*)(flg + (kt & 1) * 8); const u32x4 fa = f4[0], fb = f4[1];
          if ((fa.x & fa.y & fa.z & fa.w & fb.x & fb.y & fb.z & fb.w) != 0u) break; }
    }
#undef SB_LOAD
#undef SB_STORE
    float ss = 0.f;
#pragma unroll
    for (int et = 0; et < 2; ++et)
#pragma unroll
        for (int r = 0; r < 16; ++r) ss += o[et][r] * o[et][r];
    ss += __shfl_xor(ss, 32);
    const float rs = rsqrtf(ss * (1.f / 64.f) + EPS);
    if (32 * wid + ql < nvalid) {
        bf16_t* op = merged + (size_t)qrow * 1024 + 512 + h * 64 + 4 * hl;
#pragma unroll
        for (int et = 0; et < 2; ++et)
#pragma unroll
            for (int g = 0; g < 4; ++g) { u32x2 w; w.x = cvtpk(o[et][4 * g] * rs, o[et][4 * g + 1] * rs); w.y = cvtpk(o[et][4 * g + 2] * rs, o[et][4 * g + 3] * rs); *(u32x2*)(op + 32 * et + 8 * g) = w; }
    }
}

__device__ __forceinline__ void conv_phase(const bf16_t* hup, const float* rstd1, const float* cw, const float* cb, bf16_t* act, int half, int gtid, int nthreads) {
    for (int item = gtid; item < 1024 * 352; item += nthreads) {
        const int rg = item / 352, c = (item - rg * 352) * 8, r0 = half * 16384 + rg * 16, t0 = r0 & 2047;
        float w[2][3][8], bb[2][8];
#pragma unroll
        for (int z = 0; z < 2; ++z) {
#pragma unroll
            for (int k = 0; k < 3; ++k) { const f32x4 a = *(const f32x4*)(cw + (size_t)k * NUP + z * DFF + c), b = *(const f32x4*)(cw + (size_t)k * NUP + z * DFF + c + 4);
                w[z][k][0] = a[0]; w[z][k][1] = a[1]; w[z][k][2] = a[2]; w[z][k][3] = a[3]; w[z][k][4] = b[0]; w[z][k][5] = b[1]; w[z][k][6] = b[2]; w[z][k][7] = b[3]; }
            const f32x4 a = *(const f32x4*)(cb + z * DFF + c), b = *(const f32x4*)(cb + z * DFF + c + 4);
            bb[z][0] = a[0]; bb[z][1] = a[1]; bb[z][2] = a[2]; bb[z][3] = a[3]; bb[z][4] = b[0]; bb[z][5] = b[1]; bb[z][6] = b[2]; bb[z][7] = b[3];
        }
        float A[2][8], B[2][8], C[2][8];
#define CV_LOAD(dst, row_) do { const int rr_ = (row_); const float s_ = rstd1[rr_]; _Pragma("unroll") for (int z = 0; z < 2; ++z) { const u32x4 q_ = *(const u32x4*)(hup + (size_t)rr_ * NUP + z * DFF + c); \
            dst[z][0] = __builtin_bit_cast(float, q_.x << 16) * s_; dst[z][1] = __builtin_bit_cast(float, q_.x & 0xffff0000u) * s_; dst[z][2] = __builtin_bit_cast(float, q_.y << 16) * s_; dst[z][3] = __builtin_bit_cast(float, q_.y & 0xffff0000u) * s_; \
            dst[z][4] = __builtin_bit_cast(float, q_.z << 16) * s_; dst[z][5] = __builtin_bit_cast(float, q_.z & 0xffff0000u) * s_; dst[z][6] = __builtin_bit_cast(float, q_.w << 16) * s_; dst[z][7] = __builtin_bit_cast(float, q_.w & 0xffff0000u) * s_; } } while (0)
        CV_LOAD(A, t0 ? r0 - 2 : META0 + 14);
        CV_LOAD(B, t0 ? r0 - 1 : META0 + 15);
        for (int i = 0; i < 16; ++i) {
            const int r = r0 + i;
            CV_LOAD(C, r);
            float ov[8];
#pragma unroll
            for (int j = 0; j < 8; ++j) {
                const float g = bb[0][j] + w[0][0][j] * A[0][j] + w[0][1][j] * B[0][j] + w[0][2][j] * C[0][j];
                const float u = bb[1][j] + w[1][0][j] * A[1][j] + w[1][1][j] * B[1][j] + w[1][2][j] * C[1][j];
                ov[j] = g * __builtin_amdgcn_rcpf(1.f + __builtin_amdgcn_exp2f(-LOG2E * g)) * u;
            }
            u32x4 q; q.x = cvtpk(ov[0], ov[1]); q.y = cvtpk(ov[2], ov[3]); q.z = cvtpk(ov[4], ov[5]); q.w = cvtpk(ov[6], ov[7]);
            *(u32x4*)(act + (size_t)(r - half * 16384) * DFF + c) = q;
#pragma unroll
            for (int z = 0; z < 2; ++z)
#pragma unroll
                for (int j = 0; j < 8; ++j) { A[z][j] = B[z][j]; B[z][j] = C[z][j]; }
        }
#undef CV_LOAD
    }
}

#define XB_TMO      128
#define XB_XCNT(j)  (256  + 64 * (j))
#define XB_XSUB(j)  (1280 + 64 * (j))
#define XB_XGEN(j)  (2304 + 64 * (j))
#define XB_TOP      3328
#define XB_TOPGEN   3392
#define XCD_BAR_WORDS 3456
#define XB_SPIN_CAP (1u << 18)

__device__ __forceinline__ unsigned xb_ld(unsigned* p)              { return __hip_atomic_load(p, __ATOMIC_RELAXED, __HIP_MEMORY_SCOPE_AGENT); }
__device__ __forceinline__ unsigned xb_add(unsigned* p, unsigned v) { return __hip_atomic_fetch_add(p, v, __ATOMIC_RELAXED, __HIP_MEMORY_SCOPE_AGENT); }
__device__ __forceinline__ unsigned xb_xcc_id() { return (unsigned)__builtin_amdgcn_s_getreg((3 << 11) | 20) & 0xFu; }
#define XB_SPIN(cond, bar) do { unsigned _sp = 0; while (cond) { __builtin_amdgcn_s_sleep(1); \
    if ((++_sp & 255u) == 0u) { if (xb_ld(&(bar)[XB_TMO])) break; if (_sp > XB_SPIN_CAP) { atomicAdd(&(bar)[XB_TMO], 1u); break; } } } } while (0)

struct XcdBarrier {
    unsigned* bar; unsigned x;
    volatile LAS unsigned* st;
};

__device__ __forceinline__ XcdBarrier xcd_barrier_post(unsigned* bar, volatile LAS unsigned* st) {
    XcdBarrier b; b.bar = bar; b.x = xb_xcc_id(); b.st = st;
    if (threadIdx.x == 0) (void)xb_add(&bar[XB_XCNT(b.x)], 1u);
    return b;
}
__device__ __forceinline__ void xcd_barrier_complete(unsigned* bar, unsigned x, unsigned& nloc, unsigned& nx) {
    const unsigned G = gridDim.x * gridDim.y * gridDim.z;
    unsigned sum, cnt, mine, sp = 0u;
    for (;;) {
        sum = 0u; cnt = 0u; mine = 0u;
#pragma unroll
        for (unsigned j = 0; j < 16; ++j) { const unsigned c = xb_ld(&bar[XB_XCNT(j)]); sum += c; cnt += (c > 0u) ? 1u : 0u; mine = (j == x) ? c : mine; }
        if (sum == G) break;
        __builtin_amdgcn_s_sleep(1);
        if ((++sp & 255u) == 0u) { if (xb_ld(&bar[XB_TMO])) break; if (sp > XB_SPIN_CAP) { atomicAdd(&bar[XB_TMO], 1u); break; } }
    }
    nloc = mine > 0u ? mine : 1u; nx = cnt > 0u ? cnt : 1u;
}

__device__ __forceinline__ void xcd_barrier(const XcdBarrier& b) {
    asm volatile("s_waitcnt vmcnt(0)" ::: "memory");
    __syncthreads();
    if (threadIdx.x == 0) {
        unsigned* bar = b.bar;
        __builtin_amdgcn_s_waitcnt(0);
        unsigned nloc = b.st[0], nx = b.st[1];
        if (nloc == 0u) { xcd_barrier_complete(bar, b.x, nloc, nx); b.st[0] = nloc; b.st[1] = nx; }
        const unsigned old = xb_add(&bar[XB_XSUB(b.x)], 1u);
        const unsigned gen = old / nloc;
        if (old + 1u == (gen + 1u) * nloc) {
            __builtin_amdgcn_fence(__ATOMIC_RELEASE, "agent");
            asm volatile("s_waitcnt vmcnt(0)" ::: "memory");
            const unsigned og = xb_add(&bar[XB_TOP], 1u);
            const unsigned tg = og / nx;
            if (og + 1u == (tg + 1u) * nx) xb_add(&bar[XB_TOPGEN], 1u);
            else XB_SPIN(xb_ld(&bar[XB_TOPGEN]) == tg, bar);
            __builtin_amdgcn_fence(__ATOMIC_ACQUIRE, "agent");
            xb_add(&bar[XB_XGEN(b.x)], 1u);
            asm volatile("s_waitcnt vmcnt(0)" ::: "memory");
        } else {
            XB_SPIN(xb_ld(&bar[XB_XGEN(b.x)]) == gen, bar);
            __builtin_amdgcn_fence(__ATOMIC_ACQUIRE, "agent");
            asm volatile("s_waitcnt vmcnt(0)" ::: "memory");
        }
    }
    __syncthreads();
}


struct Args { const float* in[17]; float* out; unsigned char* ws; };
__global__ void __launch_bounds__(NTHREADS, 2) hymba_fwd(Args args) {
    extern __shared__ __attribute__((aligned(16))) unsigned char lds_raw[];
    LAS unsigned char* lds = (LAS unsigned char*)lds_raw;
    cg::grid_group grid = cg::this_grid();
    const int tid = threadIdx.x, lane = tid & 63, wave = __builtin_amdgcn_readfirstlane(tid >> 6);
    const int G = gridDim.x, bx = blockIdx.x;
    const int vcu = (G % 8 == 0) ? (bx % 8) * (G / 8) + bx / 8 : bx;
    unsigned char* ws = args.ws;
    bf16_t* XB = (bf16_t*)(ws + WS_XB); bf16_t* WIN = (bf16_t*)(ws + WS_WIN); bf16_t* WOUT = (bf16_t*)(ws + WS_WOUT); bf16_t* WUP = (bf16_t*)(ws + WS_WUP); bf16_t* WDN = (bf16_t*)(ws + WS_WDN);
    bf16_t* QK = (bf16_t*)(ws + WS_QK); bf16_t* VT = (bf16_t*)(ws + WS_VT); bf16_t* MRG = (bf16_t*)(ws + WS_MRG); bf16_t* HUP = (bf16_t*)(ws + WS_R); bf16_t* ACT = (bf16_t*)(ws + WS_ACT);
    float* PART1 = (float*)(ws + WS_PART1); float* PART2 = (float*)(ws + WS_PART2); float* RSTD1 = (float*)(ws + WS_RSTD1);
    float* OUT = args.out;
    volatile LAS unsigned* MISC = (volatile LAS unsigned*)(lds + LDS_MISC);
    if (tid < 64) MISC[tid] = 0u;
    __syncthreads();
    XcdBarrier bar = xcd_barrier_post((unsigned*)(ws + WS_CTL), MISC);

#ifndef NO_P0
    {
#ifndef NREP_P0
#define NREP_P0 1
#endif
        for (int rep = 0; rep < NREP_P0; ++rep) {
        LAS float* scr = (LAS float*)(lds + wave * 16384);
        const int gw = vcu * 8 + wave, NGW = G * 8;
        constexpr int I_IN = 16 * 96, I_OUT = 16 * 32, I_UP = 16 * 176, I_DN = 44 * 32;
        for (int it = gw; it < I_IN + I_OUT + I_UP + I_DN; it += NGW) {
            int r = it;
            if (r < I_IN) { transpose_item<1>(args.in[3], 1024, 3072, WIN, scr, r, lane, args.in[2], nullptr); continue; } r -= I_IN;
            if (r < I_OUT) { transpose_item<2>(args.in[10], 1024, 1024, WOUT, scr, r, lane, args.in[8], args.in[9]); continue; } r -= I_OUT;
            if (r < I_UP) { transpose_item<3>(args.in[12], 1024, NUP, WUP, scr, r, lane, args.in[11], nullptr); continue; } r -= I_UP;
            transpose_item<0>(args.in[15], DFF, 1024, WDN, scr, r, lane, nullptr, nullptr);
        }
        for (int mrow = gw; mrow < MP; mrow += NGW) {
            if (mrow < META0 + 16) rms_row_to_bf16(mrow < META0 ? args.in[0] + (size_t)mrow * D : args.in[1] + (size_t)(mrow - META0) * D, XB + (size_t)mrow * D, lane);
            else { u32x4 z = {0u, 0u, 0u, 0u}; ((u32x4*)(XB + (size_t)mrow * D))[lane] = z; ((u32x4*)(XB + (size_t)mrow * D))[lane + 64] = z;
                   ((u32x4*)(MRG + (size_t)mrow * D))[lane] = z; ((u32x4*)(MRG + (size_t)mrow * D))[lane + 64] = z; }
        }
        }
    }
    grid.sync();

#endif
#ifndef NO_P1
    {
        pg8::Gemm g{XB, XB, MP + 3072, MP + 3072, D};
        pg8::OrderInProj S{G, bx};
        pg8::EpiInProj E{QK, QK_STRIDE, VT, MP, 0.125f * LOG2E};
        pg8::gemm_phase<pg8::EpiInProj, pg8::OrderInProj, PG8_ALIGN, PG8_SP2>(lds, g, S, E);
    }
    xcd_barrier(bar);

#endif
#ifndef NO_P2
    {
        int tid2 = threadIdx.x; asm volatile("" : "+v"(tid2)); const int lane2 = tid2 & 63;
        const float s1 = wave_sum(args.in[4][lane2] * args.in[5][lane2]), s2 = wave_sum(args.in[6][lane2] * args.in[7][lane2]);
        const float lam = expf(s1) - expf(s2) + 0.2f;
        const bf16_t* Qd = QK; const bf16_t* Kd = QK + QK_STRIDE; const bf16_t* Qs = QK + 2 * QK_STRIDE; const bf16_t* Ks = QK + 3 * QK_STRIDE;
#ifndef NREP_P2
#define NREP_P2 1
#endif
        for (int rep = 0; rep < NREP_P2; ++rep) {
        for (int p = vcu; p < 516; p += G) {
            if (p < 512) { const int b = p >> 5, h = (p >> 3) & 3, ip = p & 7; const float cs = exp2f(-2.f * (float)(h + 1)) * LOG2E;
                for (int hf = 0; hf < 2; ++hf) { const int i = hf ? ip : 15 - ip; diff_unit(lds, Qd, Kd, VT, MRG, h, b * T, b * T + 128 * i, 16 + 128 * i, 2 * i + 2, 128, cs, lam, tid2); } }
            else { const int h = p - 512; const float cs = exp2f(-2.f * (float)(h + 1)) * LOG2E; diff_unit(lds, Qd, Kd, VT, MRG, h, 0, META0, 0, 0, 16, cs, lam, tid2); }
        }
        for (int p = vcu; p < 520; p += G) {
            if (p < 512) { const int b = p >> 5, h = (p >> 2) & 7, ip = p & 3;
                for (int hf = 0; hf < 2; ++hf) { const int i = hf ? ip : 7 - ip; sb_unit(lds, Qs, Ks, VT, MRG, h, b * T, b * T + 256 * i, 16 + 256 * i, 4 * i + 4, 256, tid2); } }
            else { const int h = p - 512; sb_unit(lds, Qs, Ks, VT, MRG, h, 0, META0, 0, 0, 16, tid2); }
        }
        }
    }
    xcd_barrier(bar);

#endif
#ifndef NO_P3
    {
        pg8::Gemm g{MRG, WOUT, MP, D, D}; pg8::StaticOrder S; S.init(MP, D, G, bx);
        pg8::EpiRes1 E{args.in[0], args.in[1], OUT, XB, PART1};
        pg8::gemm_phase<pg8::EpiRes1, pg8::StaticOrder, PG8_ALIGN, PG8_SP2>(lds, g, S, E);
    }
    xcd_barrier(bar);

#endif
#ifndef NO_P4
    {
        int tid4 = threadIdx.x; asm volatile("" : "+v"(tid4));
        for (int r = bx * NTHREADS + tid4; r < MP; r += G * NTHREADS) { const f32x4* p4 = (const f32x4*)(PART1 + (size_t)r * 16); const f32x4 a = p4[0], b = p4[1], c = p4[2], d = p4[3];
            const float ss = ((a[0] + a[1]) + (a[2] + a[3])) + ((b[0] + b[1]) + (b[2] + b[3])) + ((c[0] + c[1]) + (c[2] + c[3])) + ((d[0] + d[1]) + (d[2] + d[3]));
            RSTD1[r] = rsqrtf(ss * (1.f / D) + EPS); }
#ifndef NREP_P4
#define NREP_P4 1
#endif
        pg8::Gemm g{XB, WUP, MP, NUP, D}; pg8::StaticOrder S; S.init(MP, NUP, G, bx);
        pg8::EpiPlain E{HUP, NUP};
        for (int rep = 0; rep < NREP_P4; ++rep)
        pg8::gemm_phase<pg8::EpiPlain, pg8::StaticOrder, PG8_ALIGN, PG8_SP2>(lds, g, S, E);
    }
    xcd_barrier(bar);

#endif
#ifndef NO_P5
#ifndef NREP_CV
#define NREP_CV 1
#endif
    for (int half = 0; half < 2; ++half) {
        { int tid5 = threadIdx.x; asm volatile("" : "+v"(tid5)); for (int rep = 0; rep < NREP_CV; ++rep) conv_phase(HUP, RSTD1, args.in[13], args.in[14], ACT, half, bx * NTHREADS + tid5, G * NTHREADS); }
        xcd_barrier(bar);
        {
            pg8::Gemm g{ACT, WDN, 16384, D, DFF}; pg8::StaticOrder S; S.init(16384, D, G, bx);
            pg8::EpiRes2 E{OUT, PART2, half * 16384};
            pg8::gemm_phase<pg8::EpiRes2, pg8::StaticOrder, PG8_ALIGN, PG8_SP2>(lds, g, S, E);
        }
        xcd_barrier(bar);
    }

#endif
#ifndef NO_P7
#ifdef NEXTRA_SYNC
    for (int rep = 0; rep < NEXTRA_SYNC; ++rep) grid.sync();
#endif
    {
        int tid7 = threadIdx.x; asm volatile("" : "+v"(tid7)); const int lane7 = tid7 & 63, wave7 = __builtin_amdgcn_readfirstlane(tid7 >> 6);
        const int gw = bx * 8 + wave7, NGW = G * 8;
        const f32x4* gf = (const f32x4*)args.in[16] + lane7;
        for (int r = gw; r < MR; r += NGW) {
            const float pv = lane7 < 16 ? PART2[(size_t)r * 16 + lane7] : 0.f;
            const float rs = rsqrtf(wave_sum(pv) * (1.f / D) + EPS);
            f32x4* o = (f32x4*)(OUT + (size_t)r * D) + lane7;
#pragma unroll
            for (int j = 0; j < 4; ++j) { const f32x4 v = o[64 * j], gg = gf[64 * j]; o[64 * j] = v * rs * gg; }
        }
    }
#endif
}

extern "C" void kernel_launch(void* const* d_in, const int* in_sizes, int n_in, void* d_out, int out_size, void* d_ws, size_t ws_size, hipStream_t stream) {
    static int grid = 0;
    if (grid == 0) {
        if (n_in != 17 || out_size != MR * D || ws_size < WS_END) { fprintf(stderr, "kernel_launch: unexpected shapes (n_in %d, out %d, ws %zu < %zu)\n", n_in, out_size, ws_size, (size_t)WS_END); grid = -1; return; }
        int dev = 0, cus = 0, per_cu = 0;
        hipGetDevice(&dev); hipDeviceGetAttribute(&cus, hipDeviceAttributeMultiprocessorCount, dev);
        if (hipFuncSetAttribute((const void*)hymba_fwd, hipFuncAttributeMaxDynamicSharedMemorySize, LDS_BYTES) != hipSuccess) { fprintf(stderr, "kernel_launch: hipFuncSetAttribute failed\n"); grid = -1; return; }
        if (hipOccupancyMaxActiveBlocksPerMultiprocessor(&per_cu, (const void*)hymba_fwd, NTHREADS, LDS_BYTES) != hipSuccess || per_cu < 1) { fprintf(stderr, "kernel_launch: occupancy query says %d\n", per_cu); per_cu = 1; }
        (void)hipGetLastError();
        grid = cus;
    }
    if (grid < 0) return;
    if (hipMemsetAsync((char*)d_ws + WS_CTL, 0, CTL_BYTES, stream) != hipSuccess) { fprintf(stderr, "kernel_launch: memset failed\n"); return; }
    Args a{};
    for (int i = 0; i < 17; ++i) a.in[i] = (const float*)d_in[i];
    a.out = (float*)d_out; a.ws = (unsigned char*)d_ws;
    void* kargs[] = {&a};
    hipError_t e = hipLaunchCooperativeKernel((const void*)hymba_fwd, dim3(grid), dim3(NTHREADS), kargs, LDS_BYTES, stream);
    if (e != hipSuccess) fprintf(stderr, "kernel_launch: cooperative launch failed: %s (grid %d)\n", hipGetErrorString(e), grid);
}
```

```cpp
#include <hip/hip_runtime.h>
#include <hip/hip_cooperative_groups.h>
#include <cstdio>
#include <cstdint>
#include <cmath>
namespace cg = cooperative_groups;
namespace pg8 {
#define PG8_LAS __attribute__((address_space(3)))
typedef unsigned short bf16_t;
typedef short bf16x8 __attribute__((ext_vector_type(8)));
typedef float f32x4 __attribute__((ext_vector_type(4)));
typedef unsigned u32x4 __attribute__((ext_vector_type(4)));
constexpr int BM = 256, BK = 64, HALF = 128, HTB = HALF * BK * 2  , STAGE_BYTES = 8 * HTB, NXCD = 8, WGM = 8;

__host__ __device__ __forceinline__ int lds_byte(int r, int c) { const int st = (r >> 4) * 2 + (c >> 5), rr = r & 15, cc = c & 31, ob = rr * 64 + cc * 2; return st * 1024 + (ob ^ (((ob >> 9) & 1) << 5)); }
__host__ __device__ __forceinline__ void stage_rc(int b, int& R, int& C) { const int st = b / 1024, sb = b % 1024, swz = sb ^ (((sb >> 9) & 1) << 5); R = (st >> 1) * 16 + swz / 64; C = (st & 1) * 32 + (swz % 64) / 2; }
__host__ __device__ __forceinline__ int perm32(int rho) { const int n = rho >> 4, i = rho & 15; return 8 * (i >> 2) + 4 * n + (i & 3); }

struct Unit { int pm, pn; };
struct Gemm { const bf16_t* A; const bf16_t* Bt; int M, N, K; };

struct StaticOrder {
    int nM, nN, nwg, G, c;
    __host__ __device__ void init(int M, int N, int G_, int c_) { nM = M / BM; nN = N / BM; nwg = nM * nN; G = G_; c = c_; }
    __host__ __device__ bool next(int i, Unit& u) const {
        const long L = (long)i * G + c; if (L >= nwg) return false;
        int wgid = (int)L; { const int q = nwg / NXCD, r = nwg % NXCD, xcd = wgid % NXCD, off = wgid / NXCD; wgid = (xcd < r ? xcd * (q + 1) : r * (q + 1) + (xcd - r) * q) + off; }
        const int nig = WGM * nN, gid = wgid / nig, fm = gid * WGM, gsz = (nM - fm) < WGM ? (nM - fm) : WGM;
        u.pm = fm + ((wgid % nig) % gsz); u.pn = (wgid % nig) / gsz; return true;
    }
    __device__ __forceinline__ void a_ready(const Unit&) const {}
    __device__ __forceinline__ void done(const Unit&) const {}
};

__device__ __forceinline__ unsigned cvt_pk_bf16(float lo, float hi) { unsigned r; asm volatile("v_cvt_pk_bf16_f32 %0, %1, %2" : "=v"(r) : "v"(lo), "v"(hi)); return r; }
__device__ __forceinline__ u32x4 pack8(const f32x4 v0, const f32x4 v1) { u32x4 w; w.x = cvt_pk_bf16(v0[0], v0[1]); w.y = cvt_pk_bf16(v0[2], v0[3]); w.z = cvt_pk_bf16(v1[0], v1[1]); w.w = cvt_pk_bf16(v1[2], v1[3]); return w; }
__device__ __forceinline__ void zero_acc(f32x4 (&acc)[2][2][4][2]) {
#pragma unroll
    for (int a = 0; a < 2; ++a)
#pragma unroll
        for (int b = 0; b < 2; ++b)
#pragma unroll
            for (int m = 0; m < 4; ++m)
#pragma unroll
                for (int n = 0; n < 2; ++n) acc[a][b][m][n] = (f32x4){0.f, 0.f, 0.f, 0.f};
}
struct EpiInProj {
    static constexpr bool PERM = true, AFTER_DRAIN = false;
    bf16_t* QK; size_t qk_stride; bf16_t* Vt; int ldv; float qscale;
    __device__ __forceinline__ void init(f32x4 (&acc)[2][2][4][2], const Unit&, int, int, int, int) const { zero_acc(acc); }
    __device__ __forceinline__ void operator()(const f32x4 (&acc)[2][2][4][2], const Unit& u, int wr, int wc, int fr, int fq) const {
        bf16_t* base; int ldc, row0, col0; float sc = 1.f;
        if (u.pm < 129) { int colt = (u.pn - 129) * BM; const int t = colt >> 9; colt &= 511; base = QK + (size_t)t * qk_stride; ldc = 512; row0 = u.pm * BM; col0 = colt; if ((t & 1) == 0) sc = qscale; }
        else { base = Vt; ldc = ldv; row0 = (u.pm - 137) * BM; col0 = u.pn * BM; }
        row0 += wr * 64 + fr; col0 += wc * 32 + 8 * fq;
#pragma unroll
        for (int ai = 0; ai < 2; ++ai)
#pragma unroll
            for (int m = 0; m < 4; ++m) { bf16_t* rowp = base + (size_t)(row0 + ai * HALF + m * 16) * ldc + col0;
#pragma unroll
                for (int bj = 0; bj < 2; ++bj) *(u32x4*)(rowp + bj * HALF) = pack8(acc[ai][bj][m][0] * sc, acc[ai][bj][m][1] * sc); }
    }
};
struct EpiPlain {
    static constexpr bool PERM = true, AFTER_DRAIN = false;
    bf16_t* O; int ldc;
    __device__ __forceinline__ void init(f32x4 (&acc)[2][2][4][2], const Unit&, int, int, int, int) const { zero_acc(acc); }
    __device__ __forceinline__ void operator()(const f32x4 (&acc)[2][2][4][2], const Unit& u, int wr, int wc, int fr, int fq) const {
        const int row0 = u.pm * BM + wr * 64 + fr, col0 = u.pn * BM + wc * 32 + 8 * fq;
#pragma unroll
        for (int ai = 0; ai < 2; ++ai)
#pragma unroll
            for (int m = 0; m < 4; ++m) { bf16_t* rowp = O + (size_t)(row0 + ai * HALF + m * 16) * ldc + col0;
#pragma unroll
                for (int bj = 0; bj < 2; ++bj) *(u32x4*)(rowp + bj * HALF) = pack8(acc[ai][bj][m][0], acc[ai][bj][m][1]); }
    }
};
struct EpiRes1 {
    static constexpr bool PERM = true, AFTER_DRAIN = false;
    const float* x; const float* meta; float* h1; bf16_t* h1b; float* part;
    __device__ __forceinline__ void init(f32x4 (&acc)[2][2][4][2], const Unit& u, int wr, int wc, int fr, int fq) const {
        const int row0 = u.pm * BM + wr * 64 + fr, col0 = u.pn * BM + wc * 32 + 8 * fq;
#pragma unroll
        for (int ai = 0; ai < 2; ++ai)
#pragma unroll
            for (int m = 0; m < 4; ++m) {
                const int r = row0 + ai * HALF + m * 16; const bool real = r < 32768, hasres = r < 32784;
                const float* res = real ? x + (size_t)r * 1024 : meta + (size_t)(hasres ? r - 32768 : 0) * 1024;
#pragma unroll
                for (int bj = 0; bj < 2; ++bj) { const int c = col0 + bj * HALF;
                    if (hasres) { acc[ai][bj][m][0] = *(const f32x4*)(res + c); acc[ai][bj][m][1] = *(const f32x4*)(res + c + 4); }
                    else { acc[ai][bj][m][0] = (f32x4){0.f, 0.f, 0.f, 0.f}; acc[ai][bj][m][1] = (f32x4){0.f, 0.f, 0.f, 0.f}; } }
            }
    }
    __device__ __forceinline__ void operator()(const f32x4 (&acc)[2][2][4][2], const Unit& u, int wr, int wc, int fr, int fq) const {
        const int row0 = u.pm * BM + wr * 64 + fr, col0 = u.pn * BM + wc * 32 + 8 * fq;
#pragma unroll
        for (int ai = 0; ai < 2; ++ai)
#pragma unroll
            for (int m = 0; m < 4; ++m) {
                const int r = row0 + ai * HALF + m * 16; const bool real = r < 32768;
                float ss = 0.f;
#pragma unroll
                for (int bj = 0; bj < 2; ++bj) { const int c = col0 + bj * HALF;
                    const f32x4 v0 = acc[ai][bj][m][0], v1 = acc[ai][bj][m][1];
                    ss += (v0[0] * v0[0] + v0[1] * v0[1]) + (v0[2] * v0[2] + v0[3] * v0[3]) + (v1[0] * v1[0] + v1[1] * v1[1]) + (v1[2] * v1[2] + v1[3] * v1[3]);
                    if (real) { *(f32x4*)(h1 + (size_t)r * 1024 + c) = v0; *(f32x4*)(h1 + (size_t)r * 1024 + c + 4) = v1; }
                    *(u32x4*)(h1b + (size_t)r * 1024 + c) = pack8(v0, v1); }
                ss += __shfl_xor(ss, 16); ss += __shfl_xor(ss, 32);
                if (fq == 0) part[(size_t)r * 16 + u.pn * 4 + wc] = ss;
            }
    }
};
struct EpiRes2 {
    static constexpr bool PERM = true, AFTER_DRAIN = false;
    float* h; float* part; int rowoff;
    __device__ __forceinline__ void init(f32x4 (&acc)[2][2][4][2], const Unit& u, int wr, int wc, int fr, int fq) const {
        const int row0 = rowoff + u.pm * BM + wr * 64 + fr, col0 = u.pn * BM + wc * 32 + 8 * fq;
#pragma unroll
        for (int ai = 0; ai < 2; ++ai)
#pragma unroll
            for (int m = 0; m < 4; ++m) { const float* hr = h + (size_t)(row0 + ai * HALF + m * 16) * 1024;
#pragma unroll
                for (int bj = 0; bj < 2; ++bj) { const int c = col0 + bj * HALF; acc[ai][bj][m][0] = *(const f32x4*)(hr + c); acc[ai][bj][m][1] = *(const f32x4*)(hr + c + 4); } }
    }
    __device__ __forceinline__ void operator()(const f32x4 (&acc)[2][2][4][2], const Unit& u, int wr, int wc, int fr, int fq) const {
        const int row0 = rowoff + u.pm * BM + wr * 64 + fr, col0 = u.pn * BM + wc * 32 + 8 * fq;
#pragma unroll
        for (int ai = 0; ai < 2; ++ai)
#pragma unroll
            for (int m = 0; m < 4; ++m) {
                const int r = row0 + ai * HALF + m * 16; float* hr = h + (size_t)r * 1024;
                float ss = 0.f;
#pragma unroll
                for (int bj = 0; bj < 2; ++bj) { const int c = col0 + bj * HALF;
                    const f32x4 v0 = acc[ai][bj][m][0], v1 = acc[ai][bj][m][1];
                    ss += (v0[0] * v0[0] + v0[1] * v0[1]) + (v0[2] * v0[2] + v0[3] * v0[3]) + (v1[0] * v1[0] + v1[1] * v1[1]) + (v1[2] * v1[2] + v1[3] * v1[3]);
                    *(f32x4*)(hr + c) = v0; *(f32x4*)(hr + c + 4) = v1; }
                ss += __shfl_xor(ss, 16); ss += __shfl_xor(ss, 32);
                if (fq == 0) part[(size_t)r * 16 + u.pn * 4 + wc] = ss;
            }
    }
};
struct OrderInProj {
    int G, c;
    __device__ __forceinline__ bool next(int i, Unit& u) const {
        const int L = i * G + c; if (L >= 1548) return false;
        if (L < 1024) { const int x = L & 7, j = (L >> 3) & 31, rnd = L >> 8; u.pm = 32 * rnd + 4 * x + (j >> 3); u.pn = 129 + (j & 7); return true; }
        int V = L - 1024;
        if (V < 516) { if (V < 512) { const int x = V & 7, j = (V >> 3) & 31, r2 = V >> 8; V = r2 * 256 + x * 32 + j; } u.pm = 137 + (V & 3); u.pn = V >> 2; return true; }
        u.pm = 128; u.pn = 129 + (V - 516); return true;
    }
    __device__ __forceinline__ void a_ready(const Unit&) const {}
    __device__ __forceinline__ void done(const Unit&) const {}
};

template <class Epi, class Sched, bool ALIGN_EPI = false, bool SP2 = false>
__device__ __forceinline__ void gemm_phase(PG8_LAS unsigned char* lds, const Gemm g, const Sched& S, const Epi& E) {
    int tid_ = threadIdx.x; asm volatile("" : "+v"(tid_));
    const int tid = tid_, wid = __builtin_amdgcn_readfirstlane(tid >> 6), lane = tid & 63, wr = wid >> 2, wc = wid & 3, fr = lane & 15, fq = lane >> 4;
    const int K = g.K, nt = K / BK;
    unsigned voffA[2], voffB[2];
#pragma unroll
    for (int i = 0; i < 2; ++i) { int R, C; stage_rc(tid * 16 + i * 8192, R, C); const int Rb = Epi::PERM ? ((R & ~31) + perm32(R & 31)) : R;
        voffA[i] = (unsigned)(R * K + C) * 2u; voffB[i] = (unsigned)(Rb * K + C) * 2u; }
    const size_t kstep = (size_t)(BK * 2);
    const size_t hstep = (size_t)HALF * K * 2;
    const size_t tstep = 2 * hstep;
    const unsigned ldsw = (unsigned)wid * 1024u;
    const int aoff = lds_byte(wr * 64 + fr, fq * 8), boff = lds_byte(wc * 32 + fr, fq * 8);
#define PG8_SA(b, h) (((b) * 2 + (h)) * HTB)
#define PG8_SB(b, h) ((4 + (b) * 2 + (h)) * HTB)
#define PG8_STAGE(bufoff, gbase, voff) do { _Pragma("unroll") for (int _i = 0; _i < 2; ++_i) \
        __builtin_amdgcn_global_load_lds((const unsigned*)((const char*)(gbase) + (voff)[_i]), (PG8_LAS unsigned*)(lds + (bufoff) + ldsw + _i * 8192), 16, 0, 0); } while (0)
#define PG8_LDA(dst, b, h) do { _Pragma("unroll") for (int m = 0; m < 4; ++m) _Pragma("unroll") for (int k = 0; k < 2; ++k) dst[m][k] = *(const PG8_LAS bf16x8*)(lds + PG8_SA(b, h) + aoff + m * 2048 + k * 1024); } while (0)
#define PG8_LDB(dst, b, h) do { _Pragma("unroll") for (int n = 0; n < 2; ++n) _Pragma("unroll") for (int k = 0; k < 2; ++k) dst[n][k] = *(const PG8_LAS bf16x8*)(lds + PG8_SB(b, h) + boff + n * 2048 + k * 1024); } while (0)
#define PG8_MMA(ai, bj, At, Bt) do { __builtin_amdgcn_s_setprio(1); _Pragma("unroll") for (int m = 0; m < 4; ++m) _Pragma("unroll") for (int n = 0; n < 2; ++n) _Pragma("unroll") for (int k = 0; k < 2; ++k) \
        acc[ai][bj][m][n] = __builtin_amdgcn_mfma_f32_16x16x32_bf16(Bt[n][k], At[m][k], acc[ai][bj][m][n], 0, 0, 0); __builtin_amdgcn_s_setprio(0); } while (0)
#define PG8_WAIT_V(n) asm volatile("s_waitcnt vmcnt(" #n ")" ::: "memory")
#define PG8_WAIT_L(n) asm volatile("s_waitcnt lgkmcnt(" #n ")" ::: "memory")
#define PG8_BAR __builtin_amdgcn_s_barrier()
#define PG8_SCHED __builtin_amdgcn_sched_barrier(0)
    Unit cur, nxt; int ui = 0;
    if (!S.next(0, cur)) return;
    f32x4 acc[2][2][4][2];
    E.init(acc, cur, wr, wc, fr, fq);
    bf16x8 At[4][2], B0[2][2], B1[2][2];
    const char* cA = (const char*)g.A + (size_t)cur.pm * tstep; const char* cB = (const char*)g.Bt + (size_t)cur.pn * tstep;
    S.a_ready(cur);
    if constexpr (SP2) {
        PG8_STAGE(PG8_SB(0, 0), cB, voffB); PG8_STAGE(PG8_SB(0, 1), cB + hstep, voffB); PG8_STAGE(PG8_SA(0, 0), cA, voffA); PG8_STAGE(PG8_SA(0, 1), cA + hstep, voffA);
        if (wr == 1) PG8_BAR;
        PG8_WAIT_V(2); PG8_BAR;
        PG8_STAGE(PG8_SB(1, 0), cB + kstep, voffB); PG8_STAGE(PG8_SA(1, 0), cA + kstep, voffA); PG8_STAGE(PG8_SB(1, 1), cB + hstep + kstep, voffB);
        PG8_WAIT_V(6); PG8_BAR;
    } else {
        PG8_STAGE(PG8_SB(0, 0), cB, voffB); PG8_STAGE(PG8_SA(0, 0), cA, voffA); PG8_STAGE(PG8_SB(0, 1), cB + hstep, voffB); PG8_STAGE(PG8_SA(0, 1), cA + hstep, voffA);
        if (wr == 1) PG8_BAR;
        PG8_WAIT_V(4); PG8_BAR;
        PG8_STAGE(PG8_SB(1, 0), cB + kstep, voffB); PG8_STAGE(PG8_SA(1, 0), cA + kstep, voffA); PG8_STAGE(PG8_SB(1, 1), cB + hstep + kstep, voffB);
        PG8_WAIT_V(6); PG8_BAR;
    }
    for (;;) {
        const bool has_next = S.next(ui + 1, nxt);
        const char* nA = has_next ? (const char*)g.A + (size_t)nxt.pm * tstep : cA; const char* nB = has_next ? (const char*)g.Bt + (size_t)nxt.pn * tstep : cB;
        for (int t = 0; t < nt; t += 2) {
            const bool last = (t == nt - 2);
            const char* a1 = cA + (size_t)(t + 1) * kstep;
            const char* a2 = last ? nA : cA + (size_t)(t + 2) * kstep; const char* b2 = last ? nB : cB + (size_t)(t + 2) * kstep;
            const char* a3 = a2 + kstep; const char* b3 = b2 + kstep;
            if (last && has_next) S.a_ready(nxt);
            if constexpr (SP2) {
            PG8_LDB(B0, 0, 0); PG8_LDB(B1, 0, 1); PG8_SCHED; PG8_LDA(At, 0, 0); PG8_STAGE(PG8_SA(1, 1), a1 + hstep, voffA);
            PG8_WAIT_V(8); PG8_WAIT_L(0); PG8_BAR; PG8_MMA(0, 0, At, B0); PG8_MMA(0, 1, At, B1); PG8_BAR; PG8_SCHED;
            PG8_LDA(At, 0, 1); PG8_STAGE(PG8_SB(0, 0), b2, voffB); PG8_STAGE(PG8_SB(0, 1), b2 + hstep, voffB); PG8_STAGE(PG8_SA(0, 0), a2, voffA);
            PG8_WAIT_V(8); PG8_WAIT_L(0); PG8_BAR; PG8_MMA(1, 0, At, B0); PG8_MMA(1, 1, At, B1); PG8_BAR; PG8_SCHED;
            PG8_LDB(B0, 1, 0); PG8_LDB(B1, 1, 1); PG8_SCHED; PG8_LDA(At, 1, 0); PG8_STAGE(PG8_SA(0, 1), a2 + hstep, voffA);
            PG8_WAIT_V(8); PG8_WAIT_L(0); PG8_BAR; PG8_MMA(0, 0, At, B0); PG8_MMA(0, 1, At, B1); PG8_BAR; PG8_SCHED;
            PG8_LDA(At, 1, 1); PG8_STAGE(PG8_SB(1, 0), b3, voffB); PG8_STAGE(PG8_SB(1, 1), b3 + hstep, voffB); PG8_STAGE(PG8_SA(1, 0), a3, voffA);
            PG8_WAIT_V(8); PG8_WAIT_L(0); PG8_BAR; PG8_MMA(1, 0, At, B0); PG8_MMA(1, 1, At, B1); PG8_BAR; PG8_SCHED;
            } else {
            PG8_LDB(B0, 0, 0); PG8_SCHED; PG8_LDA(At, 0, 0); PG8_STAGE(PG8_SA(1, 1), a1 + hstep, voffA);
            PG8_WAIT_L(8); PG8_BAR; PG8_WAIT_L(0); PG8_MMA(0, 0, At, B0); PG8_BAR; PG8_SCHED;
            PG8_LDB(B1, 0, 1); PG8_STAGE(PG8_SB(0, 0), b2, voffB);
            PG8_BAR; PG8_WAIT_L(0); PG8_MMA(0, 1, At, B1); PG8_BAR;
            PG8_LDA(At, 0, 1); PG8_STAGE(PG8_SA(0, 0), a2, voffA);
            PG8_BAR; PG8_WAIT_L(0); PG8_MMA(1, 0, At, B0); PG8_BAR; PG8_SCHED;
            PG8_STAGE(PG8_SB(0, 1), b2 + hstep, voffB);
            PG8_WAIT_V(6); PG8_BAR; PG8_MMA(1, 1, At, B1); PG8_BAR;
            PG8_LDB(B0, 1, 0); PG8_SCHED; PG8_LDA(At, 1, 0); PG8_STAGE(PG8_SA(0, 1), a2 + hstep, voffA);
            PG8_WAIT_L(8); PG8_BAR; PG8_WAIT_L(0); PG8_MMA(0, 0, At, B0); PG8_BAR; PG8_SCHED;
            PG8_LDB(B1, 1, 1); PG8_STAGE(PG8_SB(1, 0), b3, voffB);
            PG8_BAR; PG8_WAIT_L(0); PG8_MMA(0, 1, At, B1); PG8_BAR;
            PG8_LDA(At, 1, 1); PG8_STAGE(PG8_SA(1, 0), a3, voffA);
            PG8_BAR; PG8_WAIT_L(0); PG8_MMA(1, 0, At, B0); PG8_BAR; PG8_SCHED;
            PG8_STAGE(PG8_SB(1, 1), b3 + hstep, voffB);
            PG8_WAIT_V(6); PG8_BAR; PG8_MMA(1, 1, At, B1); PG8_BAR;
            }
        }
        if constexpr (ALIGN_EPI) { if (wr == 0) PG8_BAR; }
        if constexpr (!Epi::AFTER_DRAIN) { E(acc, cur, wr, wc, fr, fq); S.done(cur); }
        if (!has_next) break;
        E.init(acc, nxt, wr, wc, fr, fq);
        cur = nxt; cA = nA; cB = nB; ++ui;
        if constexpr (ALIGN_EPI) { if (wr == 1) PG8_BAR; }
    }
    PG8_WAIT_V(0);
    if constexpr (!ALIGN_EPI) { if (wr == 0) PG8_BAR; }
    PG8_BAR;
    if constexpr (Epi::AFTER_DRAIN) { E.fused(acc, cur, wr, wc, fr, fq, lds, wid, lane); S.done(cur); }
#undef PG8_SA
#undef PG8_SB
#undef PG8_STAGE
#undef PG8_LDA
#undef PG8_LDB
#undef PG8_MMA
#undef PG8_WAIT_V
#undef PG8_WAIT_L
#undef PG8_BAR
#undef PG8_SCHED
}
}
#ifndef PG8_SP2
#define PG8_SP2 true
#endif
#ifndef PG8_ALIGN
#define PG8_ALIGN true
#endif

#define LAS __attribute__((address_space(3)))
typedef unsigned short bf16_t;
typedef short bf16x8 __attribute__((ext_vector_type(8)));
typedef float f32x4 __attribute__((ext_vector_type(4)));
typedef float f32x16 __attribute__((ext_vector_type(16)));
typedef unsigned u32x4 __attribute__((ext_vector_type(4)));
typedef unsigned u32x2 __attribute__((ext_vector_type(2)));
constexpr int NB = 16, T = 2048, D = 1024, MR = NB * T, MP = 33024, META0 = 32768;
constexpr int DFF = 2816, NUP = 5632;
constexpr float EPS = 1e-6f, LOG2E = 1.4426950408889634f;
constexpr size_t MiB = 1u << 20;
constexpr size_t WS_XB = 0;
constexpr size_t WS_WIN = (size_t)MP * D * 2;
constexpr size_t WS_WOUT = 71 * MiB;
constexpr size_t WS_WUP = 73 * MiB;
constexpr size_t WS_ACT = 0;
constexpr size_t WS_CTL = 88 * MiB, CTL_BYTES = 16384;
constexpr size_t WS_WDN = 90 * MiB;
constexpr size_t WS_PART1 = 96 * MiB, WS_PART2 = 99 * MiB, WS_RSTD1 = 101 * MiB;
constexpr size_t WS_R = 102 * MiB;
constexpr size_t QK_STRIDE = (size_t)MP * 512;
constexpr size_t WS_QK = WS_R, WS_VT = WS_R + 4 * QK_STRIDE * 2, WS_MRG = WS_VT + (size_t)1024 * MP * 2;
constexpr size_t WS_END = WS_R + (size_t)MP * NUP * 2;
static_assert(WS_WIN + (size_t)3072 * D * 2 <= WS_WOUT && WS_MRG + (size_t)MP * D * 2 <= WS_END && (size_t)16384 * DFF * 2 <= WS_WDN, "ws map");
constexpr int LDS_BYTES = 147456;
constexpr int NTHREADS = 512;
constexpr int LDS_MISC = 131072 + 1024;

__device__ __forceinline__ unsigned cvtpk(float lo, float hi) { typedef float f2 __attribute__((ext_vector_type(2))); typedef __bf16 b2 __attribute__((ext_vector_type(2))); f2 v = {lo, hi}; b2 b = __builtin_convertvector(v, b2); return __builtin_bit_cast(unsigned, b); }
__device__ __forceinline__ float wave_sum(float v) {
#pragma unroll
    for (int o = 1; o < 64; o <<= 1) v += __shfl_xor(v, o);
    return v;
}
#define LDS_WAIT() asm volatile("s_waitcnt lgkmcnt(0)" ::: "memory")

template <int MODE> __device__ __forceinline__ void transpose_item(const float* W, int K, int N, bf16_t* WT, LAS float* scr, int item, int lane, const float* g0, const float* g1) {
    const int nblk = N / 32, kb = item / nblk, nb = item % nblk, k0 = 64 * kb, n0 = 32 * nb;
#pragma unroll 8
    for (int i = 0; i < 32; ++i) { const int kk = 2 * i + (lane >> 5), k = k0 + kk; float s = 1.f;
        if (MODE == 1 || MODE == 3) s = g0[k];
        if (MODE == 2) s = k < 512 ? g0[k & 127] * 0.8f : g1[(k - 512) & 63];
        scr[kk * 33 + (lane & 31)] = W[(size_t)k * N + n0 + (lane & 31)] * s; }
    LDS_WAIT(); asm volatile("" ::: "memory");
    int d0 = n0;
    if (MODE == 1) { const int seg = n0 >> 9; const int ns = seg == 2 ? 4 : (seg == 3 ? 2 : (seg == 4 ? 3 : seg)); d0 = ns * 512 + (n0 & 511); }
    const int c = lane & 7;
#pragma unroll
    for (int j = 0; j < 4; ++j) { const int n = (lane >> 3) + 8 * j; const LAS float* s = scr + (8 * c) * 33 + n;
        u32x4 o; o.x = cvtpk(s[0 * 33], s[1 * 33]); o.y = cvtpk(s[2 * 33], s[3 * 33]); o.z = cvtpk(s[4 * 33], s[5 * 33]); o.w = cvtpk(s[6 * 33], s[7 * 33]);
        *(u32x4*)(WT + (size_t)(d0 + n) * K + k0 + 8 * c) = o; }
    LDS_WAIT(); asm volatile("" ::: "memory");
}
__device__ __forceinline__ void rms_row_to_bf16(const float* xrow, bf16_t* orow, int lane) {
    const f32x4* xr = (const f32x4*)xrow + lane;
    f32x4 v[4]; float s = 0.f;
#pragma unroll
    for (int j = 0; j < 4; ++j) { v[j] = xr[64 * j]; s += (v[j].x * v[j].x + v[j].y * v[j].y) + (v[j].z * v[j].z + v[j].w * v[j].w); }
    const float rs = rsqrtf(wave_sum(s) * (1.f / D) + EPS);
    u32x2* o8 = (u32x2*)orow + lane;
#pragma unroll
    for (int j = 0; j < 4; ++j) { u32x2 w; w.x = cvtpk(v[j].x * rs, v[j].y * rs); w.y = cvtpk(v[j].z * rs, v[j].w * rs); o8[64 * j] = w; }
}

constexpr int KROW = 144;
constexpr int DF_K1 = 0, DF_K2 = 64 * KROW, DF_V = 2 * 64 * KROW, DF_BUF = DF_V + 128 * KROW;
constexpr int SB_K = 0, SB_V = 64 * KROW, SB_BUF = 2 * 64 * KROW;
__device__ __forceinline__ int pi32(int r) { return (r & 0x13) | ((r & 4) << 1) | ((r & 8) >> 1); }
__device__ __forceinline__ bf16x8 pack_frag(float a0, float a1, float a2, float a3, float a4, float a5, float a6, float a7) {
    u32x4 w; w.x = cvtpk(a0, a1); w.y = cvtpk(a2, a3); w.z = cvtpk(a4, a5); w.w = cvtpk(a6, a7); return __builtin_bit_cast(bf16x8, w); }
#define MFMA32(a, b, c) __builtin_amdgcn_mfma_f32_32x32x16_bf16(a, b, c, 0, 0, 0)

__device__ __forceinline__ void diff_unit(LAS unsigned char* lds, const bf16_t* Qd, const bf16_t* Kd, const bf16_t* Vt, bf16_t* merged,
                                          int h, int krow_real, int qrow0, int qpos0, int kt_hi, int nvalid, float cs, float lam, int tid) {
    const int lane = tid & 63, wid = __builtin_amdgcn_readfirstlane(tid >> 6), map = wid >> 2, wq = wid & 3, ql = lane & 31, hl = lane >> 5;
    const int skey = tid >> 3, sch = tid & 7;
    const bf16_t* gK = Kd + (size_t)skey * 512 + h * 128 + sch * 8;
    const bf16_t* gV = Vt + (size_t)(h * 128 + skey) * MP + sch * 8;
    const int sK = skey * KROW + sch * 16;
    u32x4 rk1, rk2, rv0, rv1;
#define DF_LOAD(kt_) do { const int krow_ = (kt_) == 0 ? META0 - 48 : krow_real + 64 * ((kt_) - 1); rk1 = *(const u32x4*)(gK + (size_t)krow_ * 512); rk2 = *(const u32x4*)(gK + (size_t)krow_ * 512 + 64); \
        rv0 = *(const u32x4*)(gV + krow_); rv1 = *(const u32x4*)(gV + krow_ + (size_t)64 * MP); } while (0)
#define DF_STORE(b_) do { LAS unsigned char* d_ = lds + (b_) * DF_BUF + sK; *(LAS u32x4*)(d_ + DF_K1) = rk1; *(LAS u32x4*)(d_ + DF_K2) = rk2; *(LAS u32x4*)(d_ + DF_V) = rv0; *(LAS u32x4*)(d_ + DF_V + 64 * KROW) = rv1; } while (0)
    const int qrow = qrow0 + 32 * wq + ql, qpos = qpos0 + 32 * wq + ql, qw = qpos0 + 32 * wq;
    bf16x8 qf[4];
#pragma unroll
    for (int ks = 0; ks < 4; ++ks) qf[ks] = *(const bf16x8*)(Qd + (size_t)qrow * 512 + h * 128 + map * 64 + 16 * ks + 8 * hl);
    f32x16 o[4];
#pragma unroll
    for (int et = 0; et < 4; ++et)
#pragma unroll
        for (int r = 0; r < 16; ++r) o[et][r] = 0.f;
    float m = -INFINITY, l = 0.f;
    const int kaddr = (map ? DF_K2 : DF_K1) + pi32(ql) * KROW + 16 * hl;
    const int vaddr = DF_V + ql * KROW + 16 * hl;
    DF_LOAD(kt_hi); DF_STORE(0); __syncthreads();
#pragma unroll
    for (int ks = 0; ks < 4; ++ks) asm volatile("" : "+v"(qf[ks]));
    int buf = 0;
    for (int kt = kt_hi; kt >= 0; --kt) {
        if (kt > 0) DF_LOAD(kt - 1);
        const bool skip = (kt > 0) && (64 * kt - 48 > qw + 31);
        if (!skip) {
            const bool full = (kt > 0) && (64 * kt + 15 <= qw);
            const LAS unsigned char* Lb = lds + buf * DF_BUF;
            f32x16 sc[2];
            const float kb = cs * (float)(64 * kt - 48 + 8 * hl);
#pragma unroll
            for (int c = 0; c < 2; ++c)
#pragma unroll
                for (int r = 0; r < 16; ++r) sc[c][r] = __builtin_fmaf(cs, (float)(32 * c + 16 * (r >> 3) + (r & 7)), kb);
            { bf16x8 kf[2][4];
#pragma unroll
            for (int c = 0; c < 2; ++c)
#pragma unroll
                for (int ks = 0; ks < 4; ++ks) kf[c][ks] = *(const LAS bf16x8*)(Lb + kaddr + c * 32 * KROW + ks * 32);
#pragma unroll
            for (int ks = 0; ks < 4; ++ks)
#pragma unroll
                for (int c = 0; c < 2; ++c) sc[c] = MFMA32(kf[c][ks], qf[ks], sc[c]); }
            bf16x8 vA[4], vB[4];
#pragma unroll
            for (int et = 0; et < 4; ++et) { vA[et] = *(const LAS bf16x8*)(Lb + vaddr + et * 32 * KROW); vB[et] = *(const LAS bf16x8*)(Lb + vaddr + et * 32 * KROW + 32); }
            __builtin_amdgcn_sched_barrier(0);
            if (!full) {
                const int kp0 = 64 * kt - 48 + 8 * hl;
#pragma unroll
                for (int c = 0; c < 2; ++c)
#pragma unroll
                    for (int r = 0; r < 16; ++r) { const int kpos = kp0 + 32 * c + 16 * (r >> 3) + (r & 7); if (!(kpos >= 0 && kpos <= qpos)) sc[c][r] = -INFINITY; }
            }
            float mx = sc[0][0];
#pragma unroll
            for (int r = 1; r < 16; ++r) mx = fmaxf(mx, sc[0][r]);
#pragma unroll
            for (int r = 0; r < 16; ++r) mx = fmaxf(mx, sc[1][r]);
            mx = fmaxf(mx, __shfl_xor(mx, 32));
            if (__any(mx > m + 8.f)) {
                const float mn = fmaxf(m, mx); const float al = (m == -INFINITY) ? 0.f : __builtin_amdgcn_exp2f(m - mn);
                l *= al;
#pragma unroll
                for (int et = 0; et < 4; ++et)
#pragma unroll
                    for (int r = 0; r < 16; ++r) o[et][r] *= al;
                m = mn;
            }
            const float mref = (m == -INFINITY) ? 0.f : m;
            float ls = 0.f;
#pragma unroll
            for (int c = 0; c < 2; ++c)
#pragma unroll
                for (int r = 0; r < 16; ++r) { sc[c][r] = __builtin_amdgcn_exp2f(sc[c][r] - mref); ls += sc[c][r]; }
            l += ls;
            bf16x8 pf[2][2];
#pragma unroll
            for (int c = 0; c < 2; ++c)
#pragma unroll
                for (int s = 0; s < 2; ++s) pf[c][s] = pack_frag(sc[c][8 * s], sc[c][8 * s + 1], sc[c][8 * s + 2], sc[c][8 * s + 3], sc[c][8 * s + 4], sc[c][8 * s + 5], sc[c][8 * s + 6], sc[c][8 * s + 7]);
#pragma unroll
            for (int et = 0; et < 4; ++et) o[et] = MFMA32(vA[et], pf[0][0], o[et]);
#pragma unroll
            for (int et = 0; et < 4; ++et) vA[et] = *(const LAS bf16x8*)(Lb + vaddr + et * 32 * KROW + 64);
#pragma unroll
            for (int et = 0; et < 4; ++et) o[et] = MFMA32(vB[et], pf[0][1], o[et]);
#pragma unroll
            for (int et = 0; et < 4; ++et) vB[et] = *(const LAS bf16x8*)(Lb + vaddr + et * 32 * KROW + 96);
#pragma unroll
            for (int et = 0; et < 4; ++et) o[et] = MFMA32(vA[et], pf[1][0], o[et]);
#pragma unroll
            for (int et = 0; et < 4; ++et) o[et] = MFMA32(vB[et], pf[1][1], o[et]);
        }
        if (kt > 0) DF_STORE(buf ^ 1);
        __syncthreads();
        buf ^= 1;
    }
#undef DF_LOAD
#undef DF_STORE
    l += __shfl_xor(l, 32);
    const float inv = 1.f / l;
    LAS float* xch = (LAS float*)lds + wq * 4096 + lane;
    if (map == 1) { const float f = lam * inv;
#pragma unroll
        for (int et = 0; et < 4; ++et)
#pragma unroll
            for (int r = 0; r < 16; ++r) xch[(et * 16 + r) * 64] = o[et][r] * f; }
    __syncthreads();
    if (map == 0) {
        float ss = 0.f;
#pragma unroll
        for (int et = 0; et < 4; ++et)
#pragma unroll
            for (int r = 0; r < 16; ++r) { const float v = o[et][r] * inv - xch[(et * 16 + r) * 64]; o[et][r] = v; ss += v * v; }
        ss += __shfl_xor(ss, 32);
        const float rs = rsqrtf(ss * (1.f / 128.f) + EPS);
        if (32 * wq + ql < nvalid) {
            bf16_t* op = merged + (size_t)qrow * 1024 + h * 128 + 4 * hl;
#pragma unroll
            for (int et = 0; et < 4; ++et)
#pragma unroll
                for (int g = 0; g < 4; ++g) { u32x2 w; w.x = cvtpk(o[et][4 * g] * rs, o[et][4 * g + 1] * rs); w.y = cvtpk(o[et][4 * g + 2] * rs, o[et][4 * g + 3] * rs); *(u32x2*)(op + 32 * et + 8 * g) = w; }
        }
    }
    __syncthreads();
}

__device__ __forceinline__ void sb_unit(LAS unsigned char* lds, const bf16_t* Qs, const bf16_t* Ks, const bf16_t* Vt, bf16_t* merged,
                                        int h, int krow_real, int qrow0, int qpos0, int kt_hi, int nvalid, int tid) {
    const int lane = tid & 63, wid = __builtin_amdgcn_readfirstlane(tid >> 6), ql = lane & 31, hl = lane >> 5;
    const int skey = tid >> 3, sch = tid & 7;
    const bf16_t* gK = Ks + (size_t)skey * 512 + h * 64 + sch * 8;
    const bf16_t* gV = Vt + (size_t)(512 + h * 64 + skey) * MP + sch * 8;
    const int sK = skey * KROW + sch * 16;
    u32x4 rk, rv;
#define SB_LOAD(kt_) do { const int krow_ = (kt_) == 0 ? META0 - 48 : krow_real + 64 * ((kt_) - 1); rk = *(const u32x4*)(gK + (size_t)krow_ * 512); rv = *(const u32x4*)(gV + krow_); } while (0)
#define SB_STORE(b_) do { LAS unsigned char* d_ = lds + (b_) * SB_BUF + sK; *(LAS u32x4*)(d_ + SB_K) = rk; *(LAS u32x4*)(d_ + SB_V) = rv; } while (0)
    const int qrow = qrow0 + 32 * wid + ql, qpos = qpos0 + 32 * wid + ql, qw = qpos0 + 32 * wid;
    bf16x8 qf[4];
#pragma unroll
    for (int ks = 0; ks < 4; ++ks) qf[ks] = *(const bf16x8*)(Qs + (size_t)qrow * 512 + h * 64 + 16 * ks + 8 * hl);
    f32x16 o[2];
#pragma unroll
    for (int et = 0; et < 2; ++et)
#pragma unroll
        for (int r = 0; r < 16; ++r) o[et][r] = 0.f;
    float R = 1.f;
    LAS unsigned* flg = (LAS unsigned*)(lds + LDS_MISC + 64);
    const int kaddr = SB_K + pi32(ql) * KROW + 16 * hl;
    const int vaddr = SB_V + ql * KROW + 16 * hl;
    SB_LOAD(kt_hi); SB_STORE(0); __syncthreads();
#pragma unroll
    for (int ks = 0; ks < 4; ++ks) asm volatile("" : "+v"(qf[ks]));
    int buf = 0;
    for (int kt = kt_hi; kt >= 0; --kt) {
        if (kt > 0) SB_LOAD(kt - 1);
        const bool skip = (kt > 0) && (64 * kt - 48 >= qw + 31);
        if (!skip) {
            const bool full = (kt > 0) && (64 * kt + 15 < qw);
            const LAS unsigned char* Lb = lds + buf * SB_BUF;
            f32x16 sc[2];
#pragma unroll
            for (int c = 0; c < 2; ++c)
#pragma unroll
                for (int r = 0; r < 16; ++r) sc[c][r] = 0.f;
            { bf16x8 kf[2][4];
#pragma unroll
            for (int c = 0; c < 2; ++c)
#pragma unroll
                for (int ks = 0; ks < 4; ++ks) kf[c][ks] = *(const LAS bf16x8*)(Lb + kaddr + c * 32 * KROW + ks * 32);
#pragma unroll
            for (int ks = 0; ks < 4; ++ks)
#pragma unroll
                for (int c = 0; c < 2; ++c) sc[c] = MFMA32(kf[c][ks], qf[ks], sc[c]); }
            bf16x8 vf[2][4];
#pragma unroll
            for (int et = 0; et < 2; ++et)
#pragma unroll
                for (int i = 0; i < 4; ++i) vf[et][i] = *(const LAS bf16x8*)(Lb + vaddr + et * 32 * KROW + i * 32);
            __builtin_amdgcn_sched_barrier(0);
            bf16x8 pf[2][2];
            const int kp0 = 64 * kt - 48 + 8 * hl;
#pragma unroll
            for (int c = 1; c >= 0; --c)
#pragma unroll
                for (int s = 1; s >= 0; --s) {
                    float sg[8], ci[8];
#pragma unroll
                    for (int j = 0; j < 8; ++j) { float u = __builtin_amdgcn_exp2f(fminf(sc[c][8 * s + j], 100.f));
                        if (!full) { const int kpos = kp0 + 32 * c + 16 * s + j; if (!(kpos >= 0 && kpos < qpos)) u = 0.f; }
                        ci[j] = __builtin_amdgcn_rcpf(1.f + u); sg[j] = u * ci[j]; }
                    float e = 1.f;
#pragma unroll
                    for (int j = 7; j >= 0; --j) { sg[j] *= e; e *= ci[j]; }
                    const float ep = __shfl_xor(e, 32);
                    const float F = R * (hl ? 1.f : ep);
                    R *= e * ep;
                    pf[c][s] = pack_frag(sg[0] * F, sg[1] * F, sg[2] * F, sg[3] * F, sg[4] * F, sg[5] * F, sg[6] * F, sg[7] * F);
                }
#pragma unroll
            for (int c = 0; c < 2; ++c)
#pragma unroll
                for (int s = 0; s < 2; ++s)
#pragma unroll
                    for (int et = 0; et < 2; ++et) o[et] = MFMA32(vf[et][2 * c + s], pf[c][s], o[et]);
        }
        if (kt > 0) SB_STORE(buf ^ 1);
        if (lane == 0) flg[(kt & 1) * 8 + wid] = __all(R < 1e-30f) ? 1u : 0u;
        __syncthreads();
        buf ^= 1;
        { const LAS u32x4* f4 = (const LAS u32x4*)(flg + (kt & 1) * 8); const u32x4 fa = f4[0], fb = f4[1];
          if ((fa.x & fa.y & fa.z & fa.w & fb.x & fb.y & fb.z & fb.w) != 0u) break; }
    }
#undef SB_LOAD
#undef SB_STORE
    float ss = 0.f;
#pragma unroll
    for (int et = 0; et < 2; ++et)
#pragma unroll
        for (int r = 0; r < 16; ++r) ss += o[et][r] * o[et][r];
    ss += __shfl_xor(ss, 32);
    const float rs = rsqrtf(ss * (1.f / 64.f) + EPS);
    if (32 * wid + ql < nvalid) {
        bf16_t* op = merged + (size_t)qrow * 1024 + 512 + h * 64 + 4 * hl;
#pragma unroll
        for (int et = 0; et < 2; ++et)
#pragma unroll
            for (int g = 0; g < 4; ++g) { u32x2 w; w.x = cvtpk(o[et][4 * g] * rs, o[et][4 * g + 1] * rs); w.y = cvtpk(o[et][4 * g + 2] * rs, o[et][4 * g + 3] * rs); *(u32x2*)(op + 32 * et + 8 * g) = w; }
    }
}

__device__ __forceinline__ void conv_phase(const bf16_t* hup, const float* rstd1, const float* cw, const float* cb, bf16_t* act, int half, int gtid, int nthreads) {
    for (int item = gtid; item < 1024 * 352; item += nthreads) {
        const int rg = item / 352, c = (item - rg * 352) * 8, r0 = half * 16384 + rg * 16, t0 = r0 & 2047;
        float w[2][3][8], bb[2][8];
#pragma unroll
        for (int z = 0; z < 2; ++z) {
#pragma unroll
            for (int k = 0; k < 3; ++k) { const f32x4 a = *(const f32x4*)(cw + (size_t)k * NUP + z * DFF + c), b = *(const f32x4*)(cw + (size_t)k * NUP + z * DFF + c + 4);
                w[z][k][0] = a[0]; w[z][k][1] = a[1]; w[z][k][2] = a[2]; w[z][k][3] = a[3]; w[z][k][4] = b[0]; w[z][k][5] = b[1]; w[z][k][6] = b[2]; w[z][k][7] = b[3]; }
            const f32x4 a = *(const f32x4*)(cb + z * DFF + c), b = *(const f32x4*)(cb + z * DFF + c + 4);
            bb[z][0] = a[0]; bb[z][1] = a[1]; bb[z][2] = a[2]; bb[z][3] = a[3]; bb[z][4] = b[0]; bb[z][5] = b[1]; bb[z][6] = b[2]; bb[z][7] = b[3];
        }
        float A[2][8], B[2][8], C[2][8];
#define CV_LOAD(dst, row_) do { const int rr_ = (row_); const float s_ = rstd1[rr_]; _Pragma("unroll") for (int z = 0; z < 2; ++z) { const u32x4 q_ = *(const u32x4*)(hup + (size_t)rr_ * NUP + z * DFF + c); \
            dst[z][0] = __builtin_bit_cast(float, q_.x << 16) * s_; dst[z][1] = __builtin_bit_cast(float, q_.x & 0xffff0000u) * s_; dst[z][2] = __builtin_bit_cast(float, q_.y << 16) * s_; dst[z][3] = __builtin_bit_cast(float, q_.y & 0xffff0000u) * s_; \
            dst[z][4] = __builtin_bit_cast(float, q_.z << 16) * s_; dst[z][5] = __builtin_bit_cast(float, q_.z & 0xffff0000u) * s_; dst[z][6] = __builtin_bit_cast(float, q_.w << 16) * s_; dst[z][7] = __builtin_bit_cast(float, q_.w & 0xffff0000u) * s_; } } while (0)
        CV_LOAD(A, t0 ? r0 - 2 : META0 + 14);
        CV_LOAD(B, t0 ? r0 - 1 : META0 + 15);
        for (int i = 0; i < 16; ++i) {
            const int r = r0 + i;
            CV_LOAD(C, r);
            float ov[8];
#pragma unroll
            for (int j = 0; j < 8; ++j) {
                const float g = bb[0][j] + w[0][0][j] * A[0][j] + w[0][1][j] * B[0][j] + w[0][2][j] * C[0][j];
                const float u = bb[1][j] + w[1][0][j] * A[1][j] + w[1][1][j] * B[1][j] + w[1][2][j] * C[1][j];
                ov[j] = g * __builtin_amdgcn_rcpf(1.f + __builtin_amdgcn_exp2f(-LOG2E * g)) * u;
            }
            u32x4 q; q.x = cvtpk(ov[0], ov[1]); q.y = cvtpk(ov[2], ov[3]); q.z = cvtpk(ov[4], ov[5]); q.w = cvtpk(ov[6], ov[7]);
            *(u32x4*)(act + (size_t)(r - half * 16384) * DFF + c) = q;
#pragma unroll
            for (int z = 0; z < 2; ++z)
#pragma unroll
                for (int j = 0; j < 8; ++j) { A[z][j] = B[z][j]; B[z][j] = C[z][j]; }
        }
#undef CV_LOAD
    }
}

#define XB_TMO      128
#define XB_XCNT(j)  (256  + 64 * (j))
#define XB_XSUB(j)  (1280 + 64 * (j))
#define XB_XGEN(j)  (2304 + 64 * (j))
#define XB_TOP      3328
#define XB_TOPGEN   3392
#define XCD_BAR_WORDS 3456
#define XB_SPIN_CAP (1u << 18)

__device__ __forceinline__ unsigned xb_ld(unsigned* p)              { return __hip_atomic_load(p, __ATOMIC_RELAXED, __HIP_MEMORY_SCOPE_AGENT); }
__device__ __forceinline__ unsigned xb_add(unsigned* p, unsigned v) { return __hip_atomic_fetch_add(p, v, __ATOMIC_RELAXED, __HIP_MEMORY_SCOPE_AGENT); }
__device__ __forceinline__ unsigned xb_xcc_id() { return (unsigned)__builtin_amdgcn_s_getreg((3 << 11) | 20) & 0xFu; }
#define XB_SPIN(cond, bar) do { unsigned _sp = 0; while (cond) { __builtin_amdgcn_s_sleep(1); \
    if ((++_sp & 255u) == 0u) { if (xb_ld(&(bar)[XB_TMO])) break; if (_sp > XB_SPIN_CAP) { atomicAdd(&(bar)[XB_TMO], 1u); break; } } } } while (0)

struct XcdBarrier {
    unsigned* bar; unsigned x;
    volatile LAS unsigned* st;
};

__device__ __forceinline__ XcdBarrier xcd_barrier_post(unsigned* bar, volatile LAS unsigned* st) {
    XcdBarrier b; b.bar = bar; b.x = xb_xcc_id(); b.st = st;
    if (threadIdx.x == 0) (void)xb_add(&bar[XB_XCNT(b.x)], 1u);
    return b;
}
__device__ __forceinline__ void xcd_barrier_complete(unsigned* bar, unsigned x, unsigned& nloc, unsigned& nx) {
    const unsigned G = gridDim.x * gridDim.y * gridDim.z;
    unsigned sum, cnt, mine, sp = 0u;
    for (;;) {
        sum = 0u; cnt = 0u; mine = 0u;
#pragma unroll
        for (unsigned j = 0; j < 16; ++j) { const unsigned c = xb_ld(&bar[XB_XCNT(j)]); sum += c; cnt += (c > 0u) ? 1u : 0u; mine = (j == x) ? c : mine; }
        if (sum == G) break;
        __builtin_amdgcn_s_sleep(1);
        if ((++sp & 255u) == 0u) { if (xb_ld(&bar[XB_TMO])) break; if (sp > XB_SPIN_CAP) { atomicAdd(&bar[XB_TMO], 1u); break; } }
    }
    nloc = mine > 0u ? mine : 1u; nx = cnt > 0u ? cnt : 1u;
}

__device__ __forceinline__ void xcd_barrier(const XcdBarrier& b) {
    asm volatile("s_waitcnt vmcnt(0)" ::: "memory");
    __syncthreads();
    if (threadIdx.x == 0) {
        unsigned* bar = b.bar;
        __builtin_amdgcn_s_waitcnt(0);
        unsigned nloc = b.st[0], nx = b.st[1];
        if (nloc == 0u) { xcd_barrier_complete(bar, b.x, nloc, nx); b.st[0] = nloc; b.st[1] = nx; }
        const unsigned old = xb_add(&bar[XB_XSUB(b.x)], 1u);
        const unsigned gen = old / nloc;
        if (old + 1u == (gen + 1u) * nloc) {
            __builtin_amdgcn_fence(__ATOMIC_RELEASE, "agent");
            asm volatile("s_waitcnt vmcnt(0)" ::: "memory");
            const unsigned og = xb_add(&bar[XB_TOP], 1u);
            const unsigned tg = og / nx;
            if (og + 1u == (tg + 1u) * nx) xb_add(&bar[XB_TOPGEN], 1u);
            else XB_SPIN(xb_ld(&bar[XB_TOPGEN]) == tg, bar);
            __builtin_amdgcn_fence(__ATOMIC_ACQUIRE, "agent");
            xb_add(&bar[XB_XGEN(b.x)], 1u);
            asm volatile("s_waitcnt vmcnt(0)" ::: "memory");
        } else {
            XB_SPIN(xb_ld(&bar[XB_XGEN(b.x)]) == gen, bar);
            __builtin_amdgcn_fence(__ATOMIC_ACQUIRE, "agent");
            asm volatile("s_waitcnt vmcnt(0)" ::: "memory");
        }
    }
    __syncthreads();
}


struct Args { const float* in[17]; float* out; unsigned char* ws; };
__global__ void __launch_bounds__(NTHREADS, 2) hymba_fwd(Args args) {
    extern __shared__ __attribute__((aligned(16))) unsigned char lds_raw[];
    LAS unsigned char* lds = (LAS unsigned char*)lds_raw;
    cg::grid_group grid = cg::this_grid();
    const int tid = threadIdx.x, lane = tid & 63, wave = __builtin_amdgcn_readfirstlane(tid >> 6);
    const int G = gridDim.x, bx = blockIdx.x;
    const int vcu = (G % 8 == 0) ? (bx % 8) * (G / 8) + bx / 8 : bx;
    unsigned char* ws = args.ws;
    bf16_t* XB = (bf16_t*)(ws + WS_XB); bf16_t* WIN = (bf16_t*)(ws + WS_WIN); bf16_t* WOUT = (bf16_t*)(ws + WS_WOUT); bf16_t* WUP = (bf16_t*)(ws + WS_WUP); bf16_t* WDN = (bf16_t*)(ws + WS_WDN);
    bf16_t* QK = (bf16_t*)(ws + WS_QK); bf16_t* VT = (bf16_t*)(ws + WS_VT); bf16_t* MRG = (bf16_t*)(ws + WS_MRG); bf16_t* HUP = (bf16_t*)(ws + WS_R); bf16_t* ACT = (bf16_t*)(ws + WS_ACT);
    float* PART1 = (float*)(ws + WS_PART1); float* PART2 = (float*)(ws + WS_PART2); float* RSTD1 = (float*)(ws + WS_RSTD1);
    float* OUT = args.out;
    volatile LAS unsigned* MISC = (volatile LAS unsigned*)(lds + LDS_MISC);
    if (tid < 64) MISC[tid] = 0u;
    __syncthreads();
    XcdBarrier bar = xcd_barrier_post((unsigned*)(ws + WS_CTL), MISC);

#ifndef NO_P0
    {
#ifndef NREP_P0
#define NREP_P0 1
#endif
        for (int rep = 0; rep < NREP_P0; ++rep) {
        LAS float* scr = (LAS float*)(lds + wave * 16384);
        const int gw = vcu * 8 + wave, NGW = G * 8;
        constexpr int I_IN = 16 * 96, I_OUT = 16 * 32, I_UP = 16 * 176, I_DN = 44 * 32;
        for (int it = gw; it < I_IN + I_OUT + I_UP + I_DN; it += NGW) {
            int r = it;
            if (r < I_IN) { transpose_item<1>(args.in[3], 1024, 3072, WIN, scr, r, lane, args.in[2], nullptr); continue; } r -= I_IN;
            if (r < I_OUT) { transpose_item<2>(args.in[10], 1024, 1024, WOUT, scr, r, lane, args.in[8], args.in[9]); continue; } r -= I_OUT;
            if (r < I_UP) { transpose_item<3>(args.in[12], 1024, NUP, WUP, scr, r, lane, args.in[11], nullptr); continue; } r -= I_UP;
            transpose_item<0>(args.in[15], DFF, 1024, WDN, scr, r, lane, nullptr, nullptr);
        }
        for (int mrow = gw; mrow < MP; mrow += NGW) {
            if (mrow < META0 + 16) rms_row_to_bf16(mrow < META0 ? args.in[0] + (size_t)mrow * D : args.in[1] + (size_t)(mrow - META0) * D, XB + (size_t)mrow * D, lane);
            else { u32x4 z = {0u, 0u, 0u, 0u}; ((u32x4*)(XB + (size_t)mrow * D))[lane] = z; ((u32x4*)(XB + (size_t)mrow * D))[lane + 64] = z;
                   ((u32x4*)(MRG + (size_t)mrow * D))[lane] = z; ((u32x4*)(MRG + (size_t)mrow * D))[lane + 64] = z; }
        }
        }
    }
    if (gridDim.y > 1u) grid.sync();
    xcd_barrier(bar);

#endif
#ifndef NO_P1
    {
        pg8::Gemm g{XB, XB, MP + 3072, MP + 3072, D};
        pg8::OrderInProj S{G, bx};
        pg8::EpiInProj E{QK, QK_STRIDE, VT, MP, 0.125f * LOG2E};
#ifndef NREP_P1
#define NREP_P1 1
#endif
        for (int rep = 0; rep < NREP_P1; ++rep)
        pg8::gemm_phase<pg8::EpiInProj, pg8::OrderInProj, PG8_ALIGN, PG8_SP2>(lds, g, S, E);
    }
    xcd_barrier(bar);

#endif
#ifndef NO_P2
    {
        int tid2 = threadIdx.x; asm volatile("" : "+v"(tid2)); const int lane2 = tid2 & 63;
        const float s1 = wave_sum(args.in[4][lane2] * args.in[5][lane2]), s2 = wave_sum(args.in[6][lane2] * args.in[7][lane2]);
        const float lam = expf(s1) - expf(s2) + 0.2f;
        const bf16_t* Qd = QK; const bf16_t* Kd = QK + QK_STRIDE; const bf16_t* Qs = QK + 2 * QK_STRIDE; const bf16_t* Ks = QK + 3 * QK_STRIDE;
#ifndef NREP_P2
#define NREP_P2 1
#endif
#ifndef NREP_DF
#define NREP_DF 1
#endif
#ifndef NREP_SB
#define NREP_SB 1
#endif
        for (int rep = 0; rep < NREP_P2; ++rep) {
        for (int rep2 = 0; rep2 < NREP_DF; ++rep2)
        for (int p = vcu; p < 516; p += G) {
            if (p < 512) { const int b = p >> 5, h = (p >> 3) & 3, ip = p & 7; const float cs = exp2f(-2.f * (float)(h + 1)) * LOG2E;
                for (int hf = 0; hf < 2; ++hf) { const int i = hf ? ip : 15 - ip; diff_unit(lds, Qd, Kd, VT, MRG, h, b * T, b * T + 128 * i, 16 + 128 * i, 2 * i + 2, 128, cs, lam, tid2); } }
            else { const int h = p - 512; const float cs = exp2f(-2.f * (float)(h + 1)) * LOG2E; diff_unit(lds, Qd, Kd, VT, MRG, h, 0, META0, 0, 0, 16, cs, lam, tid2); }
        }
        for (int rep2 = 0; rep2 < NREP_SB; ++rep2)
        for (int p = vcu; p < 520; p += G) {
            if (p < 512) { const int b = p >> 5, h = (p >> 2) & 7, ip = p & 3;
                for (int hf = 0; hf < 2; ++hf) { const int i = hf ? ip : 7 - ip; sb_unit(lds, Qs, Ks, VT, MRG, h, b * T, b * T + 256 * i, 16 + 256 * i, 4 * i + 4, 256, tid2); } }
            else { const int h = p - 512; sb_unit(lds, Qs, Ks, VT, MRG, h, 0, META0, 0, 0, 16, tid2); }
        }
        }
    }
    xcd_barrier(bar);

#endif
#ifndef NO_P3
    {
        pg8::Gemm g{MRG, WOUT, MP, D, D}; pg8::StaticOrder S; S.init(MP, D, G, bx);
        pg8::EpiRes1 E{args.in[0], args.in[1], OUT, XB, PART1};
#ifndef NREP_P3
#define NREP_P3 1
#endif
        for (int rep = 0; rep < NREP_P3; ++rep)
        pg8::gemm_phase<pg8::EpiRes1, pg8::StaticOrder, PG8_ALIGN, PG8_SP2>(lds, g, S, E);
    }
    xcd_barrier(bar);

#endif
#ifndef NO_P4
    {
        int tid4 = threadIdx.x; asm volatile("" : "+v"(tid4));
        for (int r = bx * NTHREADS + tid4; r < MP; r += G * NTHREADS) { const f32x4* p4 = (const f32x4*)(PART1 + (size_t)r * 16); const f32x4 a = p4[0], b = p4[1], c = p4[2], d = p4[3];
            const float ss = ((a[0] + a[1]) + (a[2] + a[3])) + ((b[0] + b[1]) + (b[2] + b[3])) + ((c[0] + c[1]) + (c[2] + c[3])) + ((d[0] + d[1]) + (d[2] + d[3]));
            RSTD1[r] = rsqrtf(ss * (1.f / D) + EPS); }
#ifndef NREP_P4
#define NREP_P4 1
#endif
        pg8::Gemm g{XB, WUP, MP, NUP, D}; pg8::StaticOrder S; S.init(MP, NUP, G, bx);
        pg8::EpiPlain E{HUP, NUP};
        for (int rep = 0; rep < NREP_P4; ++rep)
        pg8::gemm_phase<pg8::EpiPlain, pg8::StaticOrder, PG8_ALIGN, PG8_SP2>(lds, g, S, E);
    }
    xcd_barrier(bar);

#endif
#ifndef NO_P5
#ifndef NREP_CV
#define NREP_CV 1
#endif
    for (int half = 0; half < 2; ++half) {
        { int tid5 = threadIdx.x; asm volatile("" : "+v"(tid5)); for (int rep = 0; rep < NREP_CV; ++rep) conv_phase(HUP, RSTD1, args.in[13], args.in[14], ACT, half, bx * NTHREADS + tid5, G * NTHREADS); }
        xcd_barrier(bar);
        {
            pg8::Gemm g{ACT, WDN, 16384, D, DFF}; pg8::StaticOrder S; S.init(16384, D, G, bx);
            pg8::EpiRes2 E{OUT, PART2, half * 16384};
            pg8::gemm_phase<pg8::EpiRes2, pg8::StaticOrder, PG8_ALIGN, PG8_SP2>(lds, g, S, E);
        }
        xcd_barrier(bar);
    }

#endif
#ifndef NO_P7
#ifdef NEXTRA_SYNC
    for (int rep = 0; rep < NEXTRA_SYNC; ++rep) grid.sync();
#endif
    {
        int tid7 = threadIdx.x; asm volatile("" : "+v"(tid7)); const int lane7 = tid7 & 63, wave7 = __builtin_amdgcn_readfirstlane(tid7 >> 6);
        const int gw = bx * 8 + wave7, NGW = G * 8;
        const f32x4* gf = (const f32x4*)args.in[16] + lane7;
        for (int r = gw; r < MR; r += NGW) {
            const float pv = lane7 < 16 ? PART2[(size_t)r * 16 + lane7] : 0.f;
            const float rs = rsqrtf(wave_sum(pv) * (1.f / D) + EPS);
            f32x4* o = (f32x4*)(OUT + (size_t)r * D) + lane7;
#pragma unroll
            for (int j = 0; j < 4; ++j) { const f32x4 v = o[64 * j], gg = gf[64 * j]; o[64 * j] = v * rs * gg; }
        }
    }
#endif
}

extern "C" void kernel_launch(void* const* d_in, const int* in_sizes, int n_in, void* d_out, int out_size, void* d_ws, size_t ws_size, hipStream_t stream) {
    static int grid = 0;
    if (grid == 0) {
        if (n_in != 17 || out_size != MR * D || ws_size < WS_END) { fprintf(stderr, "kernel_launch: unexpected shapes (n_in %d, out %d, ws %zu < %zu)\n", n_in, out_size, ws_size, (size_t)WS_END); grid = -1; return; }
        int dev = 0, cus = 0, per_cu = 0;
        hipGetDevice(&dev); hipDeviceGetAttribute(&cus, hipDeviceAttributeMultiprocessorCount, dev);
        if (hipFuncSetAttribute((const void*)hymba_fwd, hipFuncAttributeMaxDynamicSharedMemorySize, LDS_BYTES) != hipSuccess) { fprintf(stderr, "kernel_launch: hipFuncSetAttribute failed\n"); grid = -1; return; }
        if (hipOccupancyMaxActiveBlocksPerMultiprocessor(&per_cu, (const void*)hymba_fwd, NTHREADS, LDS_BYTES) != hipSuccess || per_cu < 1) { fprintf(stderr, "kernel_launch: occupancy query says %d\n", per_cu); per_cu = 1; }
        (void)hipGetLastError();
        grid = cus;
    }
    if (grid < 0) return;
    if (hipMemsetAsync((char*)d_ws + WS_CTL, 0, CTL_BYTES, stream) != hipSuccess) { fprintf(stderr, "kernel_launch: memset failed\n"); return; }
    Args a{};
    for (int i = 0; i < 17; ++i) a.in[i] = (const float*)d_in[i];
    a.out = (float*)d_out; a.ws = (unsigned char*)d_ws;
    void* kargs[] = {&a};
    hipError_t e = hipLaunchCooperativeKernel((const void*)hymba_fwd, dim3(grid), dim3(NTHREADS), kargs, LDS_BYTES, stream);
    if (e != hipSuccess) fprintf(stderr, "kernel_launch: cooperative launch failed: %s (grid %d)\n", hipGetErrorString(e), grid);
}
```
